# Optimizing an MI355X kernel written in HIP

```python
import jax, jax.numpy as jnp
from jax import lax
import numpy as np

D_MODEL = 1024
BATCH = 8
SEQ = 2048
DEPTH = 4
DEC_BATCH = 128
DEC_SEQ = 4
PAST_LEN = 16384
PAGE_SIZE = 128

N_MIXERS = 2
CONV_WIDTH = 3
E_CONV = D_MODEL
HG_EXPAND = 128
HG_HEADS = D_MODEL // HG_EXPAND
HG_DK = HG_EXPAND
HG_DV = D_MODEL // HG_HEADS
HG_F = HG_HEADS * HG_DK
HG_I = HG_HEADS * HG_DV
CHUNK = 32
EPS = 1e-6
N_CONV_LAYERS = (DEPTH + 1) // 2
N_HGRN_LAYERS = DEPTH // 2

kernel_name = "hybrid_shortconv_hgrn2_adaln_step"


def rmsnorm(x, g):
    xf = x.astype(jnp.float32)
    y = xf * lax.rsqrt(jnp.mean(xf * xf, axis=-1, keepdims=True) + EPS)
    return (y * g.astype(jnp.float32)).astype(x.dtype)


def ada_mod(c, w, b):
    m = jnp.einsum('bd,de->be', jax.nn.silu(c), w) + b
    shift, scale, gate = jnp.split(m, 3, axis=-1)
    return shift[:, None], scale[:, None], gate[:, None]


def short_conv_mixer(h, conv_state, w_in, conv_w, w_out):
    T = h.shape[1]
    proj = jnp.einsum('btd,de->bte', h, w_in)
    b_gate, c_gate, v, z = jnp.split(proj, 4, axis=-1)
    u = c_gate * v
    u_ext = jnp.concatenate([conv_state.astype(u.dtype), u], axis=1)
    conv = sum(u_ext[:, k:k + T] * conv_w[k] for k in range(CONV_WIDTH))
    y = b_gate * conv * jax.nn.silu(z)
    out = jnp.einsum('bte,ed->btd', y, w_out)
    return out, u_ext[:, -(CONV_WIDTH - 1):]


def _to_chunks(a, n, L):
    B = a.shape[0]
    return jnp.moveaxis(a.reshape((B, n, L) + a.shape[2:]), 1, 0)


def hgrn2_recurrence(q, k, v, logf, s0):
    B, T = q.shape[0], q.shape[1]
    L = min(CHUNK, T)
    n = -(-T // L)
    pad = n * L - T
    if pad:
        pw = ((0, 0), (0, pad), (0, 0), (0, 0))
        q, k, v, logf = (jnp.pad(a, pw) for a in (q, k, v, logf))
    qs, ks, vs, gs = (_to_chunks(a, n, L) for a in (q, k, v, logf))
    causal = jnp.tril(jnp.ones((L, L), dtype=bool))[None, :, :, None, None]

    def step(S, inp):
        qc, kc, vc, gc = inp
        G = jnp.cumsum(gc, axis=1)
        o_inter = jnp.einsum('blhk,bhkv->blhv', qc * jnp.exp(G), S)
        diff = jnp.where(causal, G[:, :, None] - G[:, None, :], -jnp.inf)
        A = jnp.einsum('bthk,btshk,bshk->bhts', qc, jnp.exp(diff), kc)
        o_intra = jnp.einsum('bhts,bshv->bthv', A, vc)
        G_last = G[:, -1]
        S_new = S * jnp.exp(G_last)[..., None] + jnp.einsum(
            'bshk,bshv->bhkv', kc * jnp.exp(G_last[:, None] - G), vc)
        return S_new, o_inter + o_intra

    S_fin, o = lax.scan(step, s0, (qs, ks, vs, gs))
    o = jnp.moveaxis(o, 0, 1).reshape(B, n * L, q.shape[2], v.shape[-1])[:, :T]
    return o, S_fin


def hgrn2_mixer(h, state, w_in, lb, onorm_g, w_out):
    B, T = h.shape[0], h.shape[1]
    proj = jnp.einsum('btd,de->bte', h, w_in)
    q, fpre, i, z = jnp.split(proj, [HG_F, 2 * HG_F, 2 * HG_F + HG_I], axis=-1)
    fpre = fpre.astype(jnp.float32)
    lbf = lb.astype(jnp.float32)
    logf = jnp.logaddexp(jnp.log(lbf), jnp.log1p(-lbf) + jax.nn.log_sigmoid(fpre))
    k = (1.0 - lbf) * jax.nn.sigmoid(-fpre)
    qf = jax.nn.silu(q.astype(jnp.float32))
    hs = lambda a, d: a.reshape(B, T, HG_HEADS, d)
    o, S_fin = hgrn2_recurrence(hs(qf, HG_DK), hs(k, HG_DK), hs(i.astype(jnp.float32), HG_DV),
                                hs(logf, HG_DK), state.astype(jnp.float32))
    o = o * lax.rsqrt(jnp.mean(o * o, axis=-1, keepdims=True) + EPS)
    o = (o * onorm_g.astype(jnp.float32).reshape(HG_HEADS, HG_DV)).reshape(B, T, HG_I)
    y = o.astype(h.dtype) * jax.nn.silu(z)
    return jnp.einsum('bte,ed->btd', y, w_out), S_fin


def trunk(x, c, conv_states, hgrn_states, norm_g, w_ada, b_ada, conv_w_in, conv_w, conv_w_out,
          hgrn_w_in, hgrn_lower_bounds, hgrn_onorm_g, hgrn_w_out, final_norm_g):
    p = jax.nn.softmax(hgrn_lower_bounds.astype(jnp.float32), axis=0)
    lbs = jnp.concatenate([jnp.zeros_like(p[:1]), jnp.cumsum(p[1:], axis=0)], axis=0)
    new_conv, new_hgrn = [], []
    for layer in range(DEPTH):
        shift, scale, gate = ada_mod(c, w_ada[layer], b_ada[layer])
        h = rmsnorm(x, norm_g[layer]) * (1.0 + scale) + shift
        j = layer // N_MIXERS
        if layer % N_MIXERS == 0:
            out, st = short_conv_mixer(h, conv_states[j], conv_w_in[j], conv_w[j], conv_w_out[j])
            new_conv.append(st)
        else:
            out, st = hgrn2_mixer(h, hgrn_states[j], hgrn_w_in[j], lbs[layer], hgrn_onorm_g[j], hgrn_w_out[j])
            new_hgrn.append(st)
        x = x + gate * out.astype(x.dtype)
    return rmsnorm(x, final_norm_g), jnp.stack(new_conv), jnp.stack(new_hgrn)


def setup_inputs(seed: int = 0) -> dict:
    key = jax.random.key(seed)
    ks = jax.random.split(key, 20)
    f32 = jnp.float32
    nrm = lambda k, shape, s: jax.random.normal(k, shape, f32) * s
    return {
        "x_prompt": nrm(ks[0], (BATCH, SEQ, D_MODEL), 1.0),
        "x_sample": nrm(ks[1], (DEC_BATCH, DEC_SEQ, D_MODEL), 1.0),
        "state_conv": nrm(ks[2], (N_CONV_LAYERS, DEC_BATCH, CONV_WIDTH - 1, E_CONV), 1.0),
        "state_hgrn": nrm(ks[3], (N_HGRN_LAYERS, DEC_BATCH, HG_HEADS, HG_DK, HG_DV), 0.5),
        "c_prompt": nrm(ks[4], (BATCH, D_MODEL), 1.0),
        "c_sample": nrm(ks[5], (DEC_BATCH, D_MODEL), 1.0),
        "norm_g": 1.0 + nrm(ks[6], (DEPTH, D_MODEL), 0.02),
        "w_ada": nrm(ks[7], (DEPTH, D_MODEL, 3 * D_MODEL), 0.3 * D_MODEL ** -0.5),
        "b_ada": nrm(ks[8], (DEPTH, 3 * D_MODEL), 0.02),
        "conv_w_in": nrm(ks[9], (N_CONV_LAYERS, D_MODEL, 4 * E_CONV), D_MODEL ** -0.5),
        "conv_w": nrm(ks[10], (N_CONV_LAYERS, CONV_WIDTH, E_CONV), CONV_WIDTH ** -0.5),
        "conv_w_out": nrm(ks[11], (N_CONV_LAYERS, E_CONV, D_MODEL), E_CONV ** -0.5),
        "hgrn_w_in": nrm(ks[12], (N_HGRN_LAYERS, D_MODEL, 2 * HG_F + 2 * HG_I), D_MODEL ** -0.5),
        "hgrn_lower_bounds": 1.0 + nrm(ks[13], (DEPTH, HG_F), 0.1),
        "hgrn_onorm_g": 1.0 + nrm(ks[14], (N_HGRN_LAYERS, HG_I), 0.02),
        "hgrn_w_out": nrm(ks[15], (N_HGRN_LAYERS, HG_I, D_MODEL), HG_I ** -0.5),
        "final_norm_g": 1.0 + nrm(ks[16], (D_MODEL,), 0.02),
    }


def reference(x_prompt, x_sample, state_conv, state_hgrn, c_prompt, c_sample, norm_g, w_ada, b_ada,
              conv_w_in, conv_w, conv_w_out, hgrn_w_in, hgrn_lower_bounds, hgrn_onorm_g, hgrn_w_out,
              final_norm_g):
    weights = (norm_g, w_ada, b_ada, conv_w_in, conv_w, conv_w_out, hgrn_w_in,
               hgrn_lower_bounds, hgrn_onorm_g, hgrn_w_out, final_norm_g)
    zero_conv = jnp.zeros((N_CONV_LAYERS, x_prompt.shape[0], CONV_WIDTH - 1, E_CONV), x_prompt.dtype)
    zero_hgrn = jnp.zeros((N_HGRN_LAYERS, x_prompt.shape[0], HG_HEADS, HG_DK, HG_DV), jnp.float32)
    y_prompt, conv_p, hgrn_p = trunk(x_prompt, c_prompt, zero_conv, zero_hgrn, *weights)
    y_sample, conv_s, hgrn_s = trunk(x_sample, c_sample, state_conv, state_hgrn, *weights)
    return (y_prompt, y_sample, conv_p, hgrn_p, conv_s, hgrn_s)
```

```cpp
#include <hip/hip_runtime.h>
#include <hip/hip_cooperative_groups.h>
#include <cstdio>
#include <cstdint>
namespace cg = cooperative_groups;
__device__ __forceinline__ int opaque_tid() { int t = (int)threadIdx.x; asm volatile("" : "+v"(t)); return t; }
__device__ __forceinline__ int opaque_bid() { int b = (int)blockIdx.x; asm volatile("" : "+s"(b)); return b; }
__device__ __forceinline__ int opaque_s(int x) { asm volatile("" : "+s"(x)); return x; }
namespace pg8 {
#define PG8_LAS __attribute__((address_space(3)))
typedef unsigned short bf16_t;
typedef short bf16x8 __attribute__((ext_vector_type(8)));
typedef float f32x4 __attribute__((ext_vector_type(4)));
typedef unsigned u32x4 __attribute__((ext_vector_type(4)));
constexpr int BM = 256, BK = 64, HALF = 128, HTB = HALF * BK * 2  , STAGE_BYTES = 8 * HTB, NXCD = 8, WGM = 8;

__host__ __device__ __forceinline__ int lds_byte(int r, int c) { const int st = (r >> 4) * 2 + (c >> 5), rr = r & 15, cc = c & 31, ob = rr * 64 + cc * 2; return st * 1024 + (ob ^ (((ob >> 9) & 1) << 5)); }
__host__ __device__ __forceinline__ void stage_rc(int b, int& R, int& C) { const int st = b / 1024, sb = b % 1024, swz = sb ^ (((sb >> 9) & 1) << 5); R = (st >> 1) * 16 + swz / 64; C = (st & 1) * 32 + (swz % 64) / 2; }
__host__ __device__ __forceinline__ int perm32(int rho) { const int n = rho >> 4, i = rho & 15; return 8 * (i >> 2) + 4 * n + (i & 3); }

struct Unit { int pm, pn; };
struct Gemm { const bf16_t* A; const bf16_t* Bt; int M, N, K; };

struct StaticOrder {
    int nM, nN, nwg, G, c;
    __host__ __device__ void init(int M, int N, int G_, int c_) { nM = M / BM; nN = N / BM; nwg = nM * nN; G = G_; c = c_; }
    __host__ __device__ bool next(int i, Unit& u) const {
        const long L = (long)i * G + c; if (L >= nwg) return false;
        int wgid = (int)L; { const int q = nwg / NXCD, r = nwg % NXCD, xcd = wgid % NXCD, off = wgid / NXCD; wgid = (xcd < r ? xcd * (q + 1) : r * (q + 1) + (xcd - r) * q) + off; }
        const int nig = WGM * nN, gid = wgid / nig, fm = gid * WGM, gsz = (nM - fm) < WGM ? (nM - fm) : WGM;
        u.pm = fm + ((wgid % nig) % gsz); u.pn = (wgid % nig) / gsz; return true;
    }
    __device__ __forceinline__ void a_ready(const Unit&) const {}
    __device__ __forceinline__ void done(const Unit&) const {}
};

__device__ __forceinline__ unsigned cvt_pk_bf16(float lo, float hi) { unsigned r; asm volatile("v_cvt_pk_bf16_f32 %0, %1, %2" : "=v"(r) : "v"(lo), "v"(hi)); return r; }
template <class Epi, class Sched, bool ALIGN_EPI = false, bool SP2 = false>
__device__ __forceinline__ void gemm_phase(PG8_LAS unsigned char* lds, const Gemm g, const Sched& S, const Epi& E) {
    const int tid = opaque_tid(), wid = __builtin_amdgcn_readfirstlane(tid >> 6), lane = tid & 63, wr = wid >> 2, wc = wid & 3, fr = lane & 15, fq = lane >> 4;
    const int K = g.K, nt = K / BK;
    unsigned voffA[2], voffB[2];
#pragma unroll
    for (int i = 0; i < 2; ++i) { int R, C; stage_rc(tid * 16 + i * 8192, R, C); const int Rb = Epi::PERM ? ((R & ~31) + perm32(R & 31)) : R;
        voffA[i] = (unsigned)(R * K + C) * 2u; voffB[i] = (unsigned)(Rb * K + C) * 2u; }
    const size_t kstep = (size_t)(BK * 2);
    const size_t hstep = (size_t)HALF * K * 2;
    const size_t tstep = 2 * hstep;
    const unsigned ldsw = (unsigned)wid * 1024u;
    const int aoff = lds_byte(wr * 64 + fr, fq * 8), boff = lds_byte(wc * 32 + fr, fq * 8);
#define PG8_SA(b, h) (((b) * 2 + (h)) * HTB)
#define PG8_SB(b, h) ((4 + (b) * 2 + (h)) * HTB)
#define PG8_STAGE(bufoff, gbase, voff) do { _Pragma("unroll") for (int _i = 0; _i < 2; ++_i) \
        __builtin_amdgcn_global_load_lds((const unsigned*)((const char*)(gbase) + (voff)[_i]), (PG8_LAS unsigned*)(lds + (bufoff) + ldsw + _i * 8192), 16, 0, 0); } while (0)
#define PG8_LDA(dst, b, h) do { _Pragma("unroll") for (int m = 0; m < 4; ++m) _Pragma("unroll") for (int k = 0; k < 2; ++k) dst[m][k] = *(const PG8_LAS bf16x8*)(lds + PG8_SA(b, h) + aoff + m * 2048 + k * 1024); } while (0)
#define PG8_LDB(dst, b, h) do { _Pragma("unroll") for (int n = 0; n < 2; ++n) _Pragma("unroll") for (int k = 0; k < 2; ++k) dst[n][k] = *(const PG8_LAS bf16x8*)(lds + PG8_SB(b, h) + boff + n * 2048 + k * 1024); } while (0)
#define PG8_MMA(ai, bj, At, Bt) do { __builtin_amdgcn_s_setprio(1); _Pragma("unroll") for (int m = 0; m < 4; ++m) _Pragma("unroll") for (int n = 0; n < 2; ++n) _Pragma("unroll") for (int k = 0; k < 2; ++k) \
        acc[ai][bj][m][n] = __builtin_amdgcn_mfma_f32_16x16x32_bf16(Bt[n][k], At[m][k], acc[ai][bj][m][n], 0, 0, 0); __builtin_amdgcn_s_setprio(0); } while (0)
#define PG8_WAIT_V(n) asm volatile("s_waitcnt vmcnt(" #n ")" ::: "memory")
#define PG8_WAIT_L(n) asm volatile("s_waitcnt lgkmcnt(" #n ")" ::: "memory")
#define PG8_BAR __builtin_amdgcn_s_barrier()
#define PG8_SCHED __builtin_amdgcn_sched_barrier(0)
    Unit cur, nxt; int ui = 0;
    if (!S.next(0, cur)) return;
    f32x4 acc[2][2][4][2];
#pragma unroll
    for (int a = 0; a < 2; ++a)
#pragma unroll
        for (int b = 0; b < 2; ++b)
#pragma unroll
            for (int m = 0; m < 4; ++m)
#pragma unroll
                for (int n = 0; n < 2; ++n) acc[a][b][m][n] = (f32x4){0.f, 0.f, 0.f, 0.f};
    bf16x8 At[4][2], B0[2][2], B1[2][2];
    const char* cA = (const char*)g.A + (size_t)cur.pm * tstep; const char* cB = (const char*)g.Bt + (size_t)cur.pn * tstep;
    S.a_ready(cur);
    if constexpr (SP2) {
        PG8_STAGE(PG8_SB(0, 0), cB, voffB); PG8_STAGE(PG8_SB(0, 1), cB + hstep, voffB); PG8_STAGE(PG8_SA(0, 0), cA, voffA); PG8_STAGE(PG8_SA(0, 1), cA + hstep, voffA);
        if (wr == 1) PG8_BAR;
        PG8_WAIT_V(2); PG8_BAR;
        PG8_STAGE(PG8_SB(1, 0), cB + kstep, voffB); PG8_STAGE(PG8_SA(1, 0), cA + kstep, voffA); PG8_STAGE(PG8_SB(1, 1), cB + hstep + kstep, voffB);
        PG8_WAIT_V(6); PG8_BAR;
    } else {
        PG8_STAGE(PG8_SB(0, 0), cB, voffB); PG8_STAGE(PG8_SA(0, 0), cA, voffA); PG8_STAGE(PG8_SB(0, 1), cB + hstep, voffB); PG8_STAGE(PG8_SA(0, 1), cA + hstep, voffA);
        if (wr == 1) PG8_BAR;
        PG8_WAIT_V(4); PG8_BAR;
        PG8_STAGE(PG8_SB(1, 0), cB + kstep, voffB); PG8_STAGE(PG8_SA(1, 0), cA + kstep, voffA); PG8_STAGE(PG8_SB(1, 1), cB + hstep + kstep, voffB);
        PG8_WAIT_V(6); PG8_BAR;
    }
    for (;;) {
        const bool has_next = S.next(ui + 1, nxt);
        const char* nA = has_next ? (const char*)g.A + (size_t)nxt.pm * tstep : cA; const char* nB = has_next ? (const char*)g.Bt + (size_t)nxt.pn * tstep : cB;
        for (int t = 0; t < nt; t += 2) {
            const bool last = (t == nt - 2);
            const char* a1 = cA + (size_t)(t + 1) * kstep;
            const char* a2 = last ? nA : cA + (size_t)(t + 2) * kstep; const char* b2 = last ? nB : cB + (size_t)(t + 2) * kstep;
            const char* a3 = a2 + kstep; const char* b3 = b2 + kstep;
            if (last && has_next) S.a_ready(nxt);
            if constexpr (SP2) {
            PG8_LDB(B0, 0, 0); PG8_LDB(B1, 0, 1); PG8_SCHED; PG8_LDA(At, 0, 0); PG8_STAGE(PG8_SA(1, 1), a1 + hstep, voffA);
            PG8_WAIT_V(8); PG8_WAIT_L(0); PG8_BAR; PG8_MMA(0, 0, At, B0); PG8_MMA(0, 1, At, B1); PG8_BAR; PG8_SCHED;
            PG8_LDA(At, 0, 1); PG8_STAGE(PG8_SB(0, 0), b2, voffB); PG8_STAGE(PG8_SB(0, 1), b2 + hstep, voffB); PG8_STAGE(PG8_SA(0, 0), a2, voffA);
            PG8_WAIT_V(8); PG8_WAIT_L(0); PG8_BAR; PG8_MMA(1, 0, At, B0); PG8_MMA(1, 1, At, B1); PG8_BAR; PG8_SCHED;
            PG8_LDB(B0, 1, 0); PG8_LDB(B1, 1, 1); PG8_SCHED; PG8_LDA(At, 1, 0); PG8_STAGE(PG8_SA(0, 1), a2 + hstep, voffA);
            PG8_WAIT_V(8); PG8_WAIT_L(0); PG8_BAR; PG8_MMA(0, 0, At, B0); PG8_MMA(0, 1, At, B1); PG8_BAR; PG8_SCHED;
            PG8_LDA(At, 1, 1); PG8_STAGE(PG8_SB(1, 0), b3, voffB); PG8_STAGE(PG8_SB(1, 1), b3 + hstep, voffB); PG8_STAGE(PG8_SA(1, 0), a3, voffA);
            PG8_WAIT_V(8); PG8_WAIT_L(0); PG8_BAR; PG8_MMA(1, 0, At, B0); PG8_MMA(1, 1, At, B1); PG8_BAR; PG8_SCHED;
            } else {
            PG8_LDB(B0, 0, 0); PG8_SCHED; PG8_LDA(At, 0, 0); PG8_STAGE(PG8_SA(1, 1), a1 + hstep, voffA);
            PG8_WAIT_L(8); PG8_BAR; PG8_WAIT_L(0); PG8_MMA(0, 0, At, B0); PG8_BAR; PG8_SCHED;
            PG8_LDB(B1, 0, 1); PG8_STAGE(PG8_SB(0, 0), b2, voffB);
            PG8_BAR; PG8_WAIT_L(0); PG8_MMA(0, 1, At, B1); PG8_BAR;
            PG8_LDA(At, 0, 1); PG8_STAGE(PG8_SA(0, 0), a2, voffA);
            PG8_BAR; PG8_WAIT_L(0); PG8_MMA(1, 0, At, B0); PG8_BAR; PG8_SCHED;
            PG8_STAGE(PG8_SB(0, 1), b2 + hstep, voffB);
            PG8_WAIT_V(6); PG8_BAR; PG8_MMA(1, 1, At, B1); PG8_BAR;
            PG8_LDB(B0, 1, 0); PG8_SCHED; PG8_LDA(At, 1, 0); PG8_STAGE(PG8_SA(0, 1), a2 + hstep, voffA);
            PG8_WAIT_L(8); PG8_BAR; PG8_WAIT_L(0); PG8_MMA(0, 0, At, B0); PG8_BAR; PG8_SCHED;
            PG8_LDB(B1, 1, 1); PG8_STAGE(PG8_SB(1, 0), b3, voffB);
            PG8_BAR; PG8_WAIT_L(0); PG8_MMA(0, 1, At, B1); PG8_BAR;
            PG8_LDA(At, 1, 1); PG8_STAGE(PG8_SA(1, 0), a3, voffA);
            PG8_BAR; PG8_WAIT_L(0); PG8_MMA(1, 0, At, B0); PG8_BAR; PG8_SCHED;
            PG8_STAGE(PG8_SB(1, 1), b3 + hstep, voffB);
            PG8_WAIT_V(6); PG8_BAR; PG8_MMA(1, 1, At, B1); PG8_BAR;
            }
        }
        if constexpr (ALIGN_EPI) { if (wr == 0) PG8_BAR; }
        if constexpr (!Epi::AFTER_DRAIN) { E(acc, cur, wr, wc, fr, fq); S.done(cur); }
        if (!has_next) break;
#pragma unroll
        for (int a = 0; a < 2; ++a)
#pragma unroll
            for (int b = 0; b < 2; ++b)
#pragma unroll
                for (int m = 0; m < 4; ++m)
#pragma unroll
                    for (int n = 0; n < 2; ++n) acc[a][b][m][n] = (f32x4){0.f, 0.f, 0.f, 0.f};
        cur = nxt; cA = nA; cB = nB; ++ui;
        if constexpr (ALIGN_EPI) { if (wr == 1) PG8_BAR; }
    }
    PG8_WAIT_V(0);
    if constexpr (!ALIGN_EPI) { if (wr == 0) PG8_BAR; }
    PG8_BAR;
    if constexpr (Epi::AFTER_DRAIN) { E.fused(acc, cur, wr, wc, fr, fq, lds, wid, lane); S.done(cur); }
#undef PG8_SA
#undef PG8_SB
#undef PG8_STAGE
#undef PG8_LDA
#undef PG8_LDB
#undef PG8_MMA
#undef PG8_WAIT_V
#undef PG8_WAIT_L
#undef PG8_BAR
#undef PG8_SCHED
}
}

constexpr int NWAVES = 8, NTHREADS = 512;
constexpr int D = 1024, MP = 16384, MS = 512, M = MP + MS, NPROJ = 4096;
constexpr int MODLD = 12288;
constexpr float EPS = 1e-6f;
constexpr size_t O_Y = 0, O_CONVP = 17301504, O_HGP = 17334272, O_CONVS = 19431424, O_HGS = 19955712;
constexpr size_t MiB = 1u << 20;
constexpr size_t WS_WCIN = 1 * MiB, WS_WHIN = 17 * MiB, WS_WCOUT = 33 * MiB, WS_WHOUT = 37 * MiB, WS_MOD = 41 * MiB, WS_ACT = 53 * MiB,
                 WS_LBS = 54 * MiB, WS_DEC = 55 * MiB, WS_HB = 57 * MiB, WS_FRQ = 90 * MiB, WS_FRK = 122 * MiB, WS_FRKT = 154 * MiB, WS_FRV = 186 * MiB,
                 WS_PROJ = 218 * MiB, WS_WADA = WS_PROJ, WS_END = 482 * MiB;
constexpr int LDS_BYTES = 147456;

#define LAS __attribute__((address_space(3)))
typedef unsigned short bf16;
typedef unsigned v4u __attribute__((ext_vector_type(4)));
typedef unsigned v2u __attribute__((ext_vector_type(2)));
typedef float f32x4 __attribute__((ext_vector_type(4)));
typedef float f32x2 __attribute__((ext_vector_type(2)));
typedef float f32x16 __attribute__((ext_vector_type(16)));
typedef short bf16x8 __attribute__((ext_vector_type(8)));
typedef __bf16 bf16x2n __attribute__((ext_vector_type(2)));
#define LDS_WAIT() asm volatile("s_waitcnt lgkmcnt(0)" ::: "memory")

__device__ __forceinline__ unsigned pk2(float lo, float hi) { f32x2 v = {lo, hi}; return __builtin_bit_cast(unsigned, __builtin_convertvector(v, bf16x2n)); }
__device__ __forceinline__ unsigned short f2bf(float f) { return (unsigned short)(pk2(f, 0.f) & 0xffffu); }
__device__ __forceinline__ float sigmoidf_(float x) { return 1.f / (1.f + __expf(-x)); }
__device__ __forceinline__ float siluf_(float x) { return x * sigmoidf_(x); }
__device__ __forceinline__ float wave_sum(float v) {
#pragma unroll
    for (int o = 1; o < 64; o <<= 1) v += __shfl_xor(v, o);
    return v;
}
__device__ __forceinline__ int mod_row(int r) { return r < MP ? (r >> 11) : 8 + ((r - MP) >> 2); }

struct Params {
    const float* x_prompt; const float* x_sample; const float* state_conv; const float* state_hgrn;
    const float* c_prompt; const float* c_sample; const float* norm_g; const float* w_ada; const float* b_ada;
    const float* conv_w_in; const float* conv_w; const float* conv_w_out; const float* hgrn_w_in;
    const float* hgrn_lb; const float* hgrn_onorm_g; const float* hgrn_w_out; const float* final_norm_g;
    float* out; unsigned char* ws;
};


typedef const Params __attribute__((address_space(4))) * KPtr;
__device__ __forceinline__ KPtr kparams() { KPtr q = (KPtr)__builtin_amdgcn_kernarg_segment_ptr(); asm volatile("" : "+s"(q)); return q; }
#define KP(field) (kparams()->field)

struct EpiStoreF32 {
    static constexpr bool PERM = false, AFTER_DRAIN = false;
    float* C; int ldc; const float* bias;
    __device__ __forceinline__ void operator()(const f32x4 (&acc)[2][2][4][2], const pg8::Unit& u, int wr, int wc, int fr, int fq) const {
        const int row0 = u.pm * 256 + wr * 64 + fr, col0 = u.pn * 256 + wc * 32 + 4 * fq;
        f32x4 bv[2][2];
#pragma unroll
        for (int bj = 0; bj < 2; ++bj)
#pragma unroll
            for (int n = 0; n < 2; ++n) bv[bj][n] = bias ? *(const f32x4*)(bias + col0 + bj * 128 + n * 16) : (f32x4){0.f, 0.f, 0.f, 0.f};
#pragma unroll
        for (int ai = 0; ai < 2; ++ai)
#pragma unroll
            for (int m = 0; m < 4; ++m) { float* rowp = C + (size_t)(row0 + ai * 128 + m * 16) * ldc + col0;
#pragma unroll
                for (int bj = 0; bj < 2; ++bj)
#pragma unroll
                    for (int n = 0; n < 2; ++n) *(f32x4*)(rowp + bj * 128 + n * 16) = acc[ai][bj][m][n] + bv[bj][n]; }
    }
};
struct EpiResid {
    static constexpr bool PERM = false, AFTER_DRAIN = false;
    const float* xp; const float* xs;
    float* X; const float* gate;
    __device__ __forceinline__ void operator()(const f32x4 (&acc)[2][2][4][2], const pg8::Unit& u, int wr, int wc, int fr, int fq) const {
        const int row0 = u.pm * 256 + wr * 64 + fr, col0 = u.pn * 256 + wc * 32 + 4 * fq;
#pragma unroll
        for (int ai = 0; ai < 2; ++ai)
#pragma unroll
            for (int m = 0; m < 4; ++m) {
                const int r = row0 + ai * 128 + m * 16;
                const float* xo = (r < MP) ? xp + (size_t)r * D : xs + (size_t)(r - MP) * D;
                const float* gp = gate + (size_t)mod_row(r) * MODLD;
                float* xn = X + (size_t)r * D;
#pragma unroll
                for (int bj = 0; bj < 2; ++bj)
#pragma unroll
                    for (int n = 0; n < 2; ++n) { const int c = col0 + bj * 128 + n * 16;
                        const f32x4 xv = *(const f32x4*)(xo + c), gv = *(const f32x4*)(gp + c);
                        *(f32x4*)(xn + c) = xv + gv * acc[ai][bj][m][n]; } }
    }
};

__device__ __forceinline__ int src_col(int mode, int np) {
    if (mode == 0) return np;
    if (mode == 1) { const int pn = np >> 8, cl = np & 255, bj = cl >> 7, wc = (cl >> 5) & 3, n = (cl >> 4) & 1, rest = cl & 15;
        return (2 * bj + n) * 1024 + 64 * pn + 16 * wc + rest; }
    const int pn = np >> 8, bj = (np >> 7) & 1, idx = np & 127;
    return pn < 8 ? bj * 1024 + 128 * pn + idx : 2048 + bj * 1024 + 128 * (pn - 8) + idx;
}
__device__ __forceinline__ void transpose_item(const float* W, int N, bf16* WT, int row_off, int mode, LAS float* scr, int item, int lane) {
    const int nblk = N / 32, kb = item / nblk, nb = item % nblk, k0 = 64 * kb, n0 = 32 * nb;
    const int sc = src_col(mode, n0 + (lane & 31));
#pragma unroll 8
    for (int i = 0; i < 32; ++i) { const int kk = 2 * i + (lane >> 5); scr[kk * 33 + (lane & 31)] = W[(size_t)(k0 + kk) * N + sc]; }
    LDS_WAIT(); asm volatile("" ::: "memory");
    const int c = lane & 7;
#pragma unroll
    for (int j = 0; j < 4; ++j) { const int n = (lane >> 3) + 8 * j; const LAS float* s = scr + (8 * c) * 33 + n;
        v4u o; o.x = pk2(s[0 * 33], s[1 * 33]); o.y = pk2(s[2 * 33], s[3 * 33]); o.z = pk2(s[4 * 33], s[5 * 33]); o.w = pk2(s[6 * 33], s[7 * 33]);
        *(v4u*)(WT + (size_t)(row_off + n0 + n) * 1024 + k0 + 8 * c) = o; }
    LDS_WAIT(); asm volatile("" ::: "memory");
}

__device__ __forceinline__ void phase_prologue(LAS unsigned char* lds, int G) {
    const KPtr p = kparams();
    const int tid = opaque_tid(), lane = tid & 63, wave = tid >> 6;
    const int gw = opaque_bid() * NWAVES + wave, NGW = G * NWAVES;
    LAS float* scr = (LAS float*)(lds + wave * 16384);
    unsigned char* ws = p->ws;
    constexpr int I_IN = 16 * 128, I_OUT = 16 * 32, I_ADA = 16 * 96;
    constexpr int NITEMS = 4 * I_IN + 4 * I_OUT + 4 * I_ADA;
    for (int it = gw; it < NITEMS; it += NGW) {
        int r = it;
        if (r < 4 * I_ADA) { const int l = r / I_ADA; transpose_item(p->w_ada + (size_t)l * 1024 * 3072, 3072, (bf16*)(ws + WS_WADA), l * 3072, 0, scr, r % I_ADA, lane); continue; } r -= 4 * I_ADA;
        if (r < 2 * I_IN) { const int j = r / I_IN; transpose_item(p->conv_w_in + (size_t)j * 1024 * 4096, 4096, (bf16*)(ws + WS_WCIN) + (size_t)j * 4096 * 1024, 0, 1, scr, r % I_IN, lane); continue; } r -= 2 * I_IN;
        if (r < 2 * I_IN) { const int j = r / I_IN; transpose_item(p->hgrn_w_in + (size_t)j * 1024 * 4096, 4096, (bf16*)(ws + WS_WHIN) + (size_t)j * 4096 * 1024, 0, 2, scr, r % I_IN, lane); continue; } r -= 2 * I_IN;
        if (r < 2 * I_OUT) { const int j = r / I_OUT; transpose_item(p->conv_w_out + (size_t)j * 1024 * 1024, 1024, (bf16*)(ws + WS_WCOUT) + (size_t)j * 1024 * 1024, 0, 0, scr, r % I_OUT, lane); continue; } r -= 2 * I_OUT;
        { const int j = r / I_OUT; transpose_item(p->hgrn_w_out + (size_t)j * 1024 * 1024, 1024, (bf16*)(ws + WS_WHOUT) + (size_t)j * 1024 * 1024, 0, 0, scr, r % I_OUT, lane); }
    }
    const int gt = opaque_bid() * NTHREADS + tid, NGT = G * NTHREADS;
    bf16* act = (bf16*)(ws + WS_ACT);
    for (int i = gt; i < 256 * 1024; i += NGT) { const int r = i >> 10, d = i & 1023;
        float v = 0.f; if (r < 8) v = siluf_(p->c_prompt[r * 1024 + d]); else if (r < 136) v = siluf_(p->c_sample[(r - 8) * 1024 + d]);
        act[i] = f2bf(v); }
    float* lbs = (float*)(ws + WS_LBS);
    for (int e = gt; e < 1024; e += NGT) {
        const float a0 = p->hgrn_lb[e], a1 = p->hgrn_lb[1024 + e], a2 = p->hgrn_lb[2048 + e], a3 = p->hgrn_lb[3072 + e];
        const float mx = fmaxf(fmaxf(a0, a1), fmaxf(a2, a3));
        const float e0 = __expf(a0 - mx), e1 = __expf(a1 - mx), e2 = __expf(a2 - mx), e3 = __expf(a3 - mx), inv = 1.f / (e0 + e1 + e2 + e3);
        lbs[e] = 0.f; lbs[1024 + e] = e1 * inv; lbs[2048 + e] = (e1 + e2) * inv; lbs[3072 + e] = (e1 + e2 + e3) * inv; }
}

__device__ __forceinline__ void phase_norm(int layer, int G) {
    const KPtr p = kparams();
    const int tid = opaque_tid(), lane = tid & 63, wave = tid >> 6;
    const int gw = opaque_bid() * NWAVES + wave, NGW = G * NWAVES;
    const float* mod = (const float*)(p->ws + WS_MOD) + layer * 3072;
    const float* X = p->out + O_Y;
    bf16* HB = (bf16*)(p->ws + WS_HB);
    const f32x4* g4 = (const f32x4*)(p->norm_g + layer * D) + lane;
    for (int r = gw; r < M; r += NGW) {
        const float* xrow = (layer == 0) ? (r < MP ? p->x_prompt + (size_t)r * D : p->x_sample + (size_t)(r - MP) * D) : X + (size_t)r * D;
        const f32x4* xr = (const f32x4*)xrow + lane;
        f32x4 v[4]; float s = 0.f;
#pragma unroll
        for (int j = 0; j < 4; ++j) { v[j] = xr[64 * j]; s += (v[j].x * v[j].x + v[j].y * v[j].y) + (v[j].z * v[j].z + v[j].w * v[j].w); }
        const float rstd = 1.f / sqrtf(wave_sum(s) * (1.f / D) + EPS);
        const float* mr = mod + (size_t)mod_row(r) * MODLD;
        const f32x4* sh4 = (const f32x4*)mr + lane; const f32x4* sc4 = (const f32x4*)(mr + 1024) + lane;
        v2u* o8 = (v2u*)(HB + (size_t)r * D) + lane;
#pragma unroll
        for (int j = 0; j < 4; ++j) { const f32x4 g = g4[64 * j], sh = sh4[64 * j], sc = sc4[64 * j];
            const f32x4 h = v[j] * rstd * g * (sc + 1.f) + sh;
            v2u w; w.x = pk2(h.x, h.y); w.y = pk2(h.z, h.w); o8[64 * j] = w; }
    }
}

__device__ __forceinline__ void phase_final(int G) {
    const KPtr p = kparams();
    const int tid = opaque_tid(), lane = tid & 63, wave = tid >> 6;
    const int gw = opaque_bid() * NWAVES + wave, NGW = G * NWAVES;
    float* X = p->out + O_Y;
    const f32x4* g4 = (const f32x4*)p->final_norm_g + lane;
    for (int r = gw; r < M; r += NGW) {
        f32x4* xr = (f32x4*)(X + (size_t)r * D) + lane;
        f32x4 v[4]; float s = 0.f;
#pragma unroll
        for (int j = 0; j < 4; ++j) { v[j] = xr[64 * j]; s += (v[j].x * v[j].x + v[j].y * v[j].y) + (v[j].z * v[j].z + v[j].w * v[j].w); }
        const float rstd = 1.f / sqrtf(wave_sum(s) * (1.f / D) + EPS);
#pragma unroll
        for (int j = 0; j < 4; ++j) xr[64 * j] = v[j] * rstd * g4[64 * j];
    }
}

__device__ __forceinline__ void phase_conv_y(int j, int G) {
    const KPtr p = kparams();
    const int tid = opaque_tid();
    const float* PROJ = (const float*)(p->ws + WS_PROJ);
    bf16* YB = (bf16*)(p->ws + WS_HB);
    const float* cw = p->conv_w + (size_t)j * 3 * 1024;
    constexpr int RUN = 32, NRUN = M / RUN;
    for (int it = opaque_bid(); it < NRUN * 2; it += G) {
        const int run = it >> 1, e = (it & 1) * 512 + tid, r0 = run * RUN;
        const float w0 = cw[e], w1 = cw[1024 + e], w2 = cw[2048 + e];
        const int pc = 256 * (e >> 6) + 32 * ((e >> 4) & 3) + (e & 15);
        float u1 = 0.f, u2 = 0.f;
        for (int i = 0; i < RUN; ++i) {
            const int r = r0 + i;
            int t, T, seq; bool samp = r >= MP;
            if (!samp) { t = r & 2047; T = 2048; seq = r >> 11; } else { t = (r - MP) & 3; T = 4; seq = (r - MP) >> 2; }
            if (t == 0) {
                if (samp) { const float* st = p->state_conv + ((size_t)(j * 128 + seq) * 2) * 1024; u2 = st[e]; u1 = st[1024 + e]; } else { u1 = 0.f; u2 = 0.f; }
            } else if (i == 0) {
                const float* q1 = PROJ + (size_t)(r - 1) * NPROJ + pc, * q2 = PROJ + (size_t)(r - 2) * NPROJ + pc;
                u1 = q1[16] * q1[128]; u2 = q2[16] * q2[128];
            }
            const float* pr = PROJ + (size_t)r * NPROJ + pc;
            const float bb = pr[0], cc = pr[16], vv = pr[128], zz = pr[144];
            const float u0 = cc * vv;
            const float conv = w0 * u2 + w1 * u1 + w2 * u0;
            YB[(size_t)r * D + e] = f2bf(bb * conv * siluf_(zz));
            if (t >= T - 2) {
                float* dst = samp ? p->out + O_CONVS + ((size_t)(j * 128 + seq) * 2 + (t - (T - 2))) * 1024 : p->out + O_CONVP + ((size_t)(j * 8 + seq) * 2 + (t - (T - 2))) * 1024;
                dst[e] = u0;
            }
            u2 = u1; u1 = u0;
        }
    }
}

__device__ __forceinline__ int pq(int e) { return 256 * (e >> 7) + (e & 127); }
__device__ __forceinline__ void phase_hgrn_prep(int layer, int G) {
    const KPtr p = kparams();
    const int tid = opaque_tid();
    const float* PROJ = (const float*)(p->ws + WS_PROJ);
    bf16* FRQ = (bf16*)(p->ws + WS_FRQ); bf16* FRK = (bf16*)(p->ws + WS_FRK); bf16* FRKT = (bf16*)(p->ws + WS_FRKT); bf16* FRV = (bf16*)(p->ws + WS_FRV);
    float* DEC = (float*)(p->ws + WS_DEC);
    const float* lbs = (const float*)(p->ws + WS_LBS) + layer * 1024;
    for (int it = opaque_bid(); it < 8 * 64 * 2; it += G) {
        const int bc = it >> 1, b = bc >> 6, c = bc & 63, e = (it & 1) * 512 + tid;
        const int h = e >> 7, k = e & 127, kt = k >> 5, kl = k & 31;
        const int ksk = kl >> 4, rem = kl & 15, hfk = (rem >> 2) & 1, jk = ((rem >> 3) << 2) | (rem & 3);
        const int vs = kt, vl = kl;
        const size_t base = ((size_t)((b * 8 + h) * 64 + c)) * 4096;
        const float lb = lbs[e];
        const int col = pq(e);
        float Gc = 0.f;
        for (int tg = 0; tg < 8; ++tg) {
            float kv[4], vv[4];
#pragma unroll
            for (int tt = 0; tt < 4; ++tt) {
                const int t = 4 * tg + tt;
                const float* pr = PROJ + (size_t)(b * 2048 + c * 32 + t) * NPROJ + col;
                const float q = pr[0], fp = pr[128], v = pr[2048];
                const float f = lb + (1.f - lb) * sigmoidf_(fp);
                Gc += __logf(f);
                const float qt = siluf_(q) * __expf(Gc), ktl = (1.f - f) * __expf(-Gc);
                const size_t o = base + ((size_t)((kt * 2 + ksk) * 64 + t + 32 * hfk)) * 8 + jk;
                FRQ[o] = f2bf(qt); FRK[o] = f2bf(ktl);
                kv[tt] = ktl; vv[tt] = v;
            }
            const int kss = tg >> 2, hfs = tg & 1, j0 = ((tg >> 1) & 1) * 4;
            v2u w; w.x = pk2(kv[0], kv[1]); w.y = pk2(kv[2], kv[3]);
            *(v2u*)(FRKT + base + ((size_t)((kt * 2 + kss) * 64 + kl + 32 * hfs)) * 8 + j0) = w;
            w.x = pk2(vv[0], vv[1]); w.y = pk2(vv[2], vv[3]);
            *(v2u*)(FRV + base + ((size_t)((vs * 2 + kss) * 64 + vl + 32 * hfs)) * 8 + j0) = w;
        }
        DEC[(size_t)(b * 64 + c) * 1024 + e] = __expf(Gc);
    }
}

#define MFMA32(a, b, c) __builtin_amdgcn_mfma_f32_32x32x16_bf16((a), (b), (c), 0, 0, 0)
__device__ __forceinline__ bf16x8 pack8(const f32x16& x, int s) {
    v4u w; w.x = pk2(x[8 * s + 0], x[8 * s + 1]); w.y = pk2(x[8 * s + 2], x[8 * s + 3]); w.z = pk2(x[8 * s + 4], x[8 * s + 5]); w.w = pk2(x[8 * s + 6], x[8 * s + 7]);
    return __builtin_bit_cast(bf16x8, w);
}
__device__ __forceinline__ void hgrn_prompt_item(int j, int item, int lane) {
    const KPtr p = kparams();
    const int b = item >> 5, h = (item >> 2) & 7, vs = item & 3, hf = lane >> 5, l31 = lane & 31;
    const bf16* FRQ = (const bf16*)(p->ws + WS_FRQ); const bf16* FRK = (const bf16*)(p->ws + WS_FRK); const bf16* FRKT = (const bf16*)(p->ws + WS_FRKT); const bf16* FRV = (const bf16*)(p->ws + WS_FRV);
    const float* DEC = (const float*)(p->ws + WS_DEC);
    float* O = (float*)(p->ws + WS_PROJ);
    f32x16 S[4];
#pragma unroll
    for (int kt = 0; kt < 4; ++kt)
#pragma unroll
        for (int i = 0; i < 16; ++i) S[kt][i] = 0.f;
    for (int c = 0; c < 64; ++c) {
        const size_t base = ((size_t)((b * 8 + h) * 64 + c)) * 4096;
        const bf16x8* qp = (const bf16x8*)(FRQ + base) + lane; const bf16x8* kp = (const bf16x8*)(FRK + base) + lane;
        const bf16x8* ktp = (const bf16x8*)(FRKT + base) + lane; const bf16x8* vp = (const bf16x8*)(FRV + base) + vs * 128 + lane;
        bf16x8 QF[8], KF[8], KT[8], VF[2];
#pragma unroll
        for (int f = 0; f < 8; ++f) { QF[f] = qp[f * 64]; KF[f] = kp[f * 64]; KT[f] = ktp[f * 64]; }
        VF[0] = vp[0]; VF[1] = vp[64];
        const float* dp = DEC + (size_t)(b * 64 + c) * 1024 + h * 128 + 4 * hf;
        f32x16 at;
#pragma unroll
        for (int i = 0; i < 16; ++i) at[i] = 0.f;
#pragma unroll
        for (int f = 0; f < 8; ++f) at = MFMA32(KF[f], QF[f], at);
#pragma unroll
        for (int i = 0; i < 16; ++i) { const int s = (i & 3) + 8 * (i >> 2) + 4 * hf; at[i] = (s <= l31) ? at[i] : 0.f; }
        const bf16x8 atp0 = pack8(at, 0), atp1 = pack8(at, 1);
        f32x16 o;
#pragma unroll
        for (int i = 0; i < 16; ++i) o[i] = 0.f;
#pragma unroll
        for (int kt = 0; kt < 4; ++kt) { o = MFMA32(pack8(S[kt], 0), QF[kt * 2], o); o = MFMA32(pack8(S[kt], 1), QF[kt * 2 + 1], o); }
        o = MFMA32(VF[0], atp0, o); o = MFMA32(VF[1], atp1, o);
        float* orow = O + (size_t)(b * 2048 + c * 32 + l31) * NPROJ + 256 * h + 32 * vs + 4 * hf;
#pragma unroll
        for (int g = 0; g < 4; ++g) *(f32x4*)(orow + 8 * g) = (f32x4){o[4 * g], o[4 * g + 1], o[4 * g + 2], o[4 * g + 3]};
#pragma unroll
        for (int kt = 0; kt < 4; ++kt) {
            S[kt] = MFMA32(KT[kt * 2], VF[0], S[kt]); S[kt] = MFMA32(KT[kt * 2 + 1], VF[1], S[kt]);
#pragma unroll
            for (int g = 0; g < 4; ++g) { const f32x4 d = *(const f32x4*)(dp + 32 * kt + 8 * g);
                S[kt][4 * g] *= d.x; S[kt][4 * g + 1] *= d.y; S[kt][4 * g + 2] *= d.z; S[kt][4 * g + 3] *= d.w; }
        }
    }
    float* so = p->out + O_HGP + ((size_t)((j * 8 + b) * 8 + h)) * 16384 + 32 * vs + l31;
#pragma unroll
    for (int kt = 0; kt < 4; ++kt)
#pragma unroll
        for (int i = 0; i < 16; ++i) so[(size_t)(32 * kt + (i & 3) + 8 * (i >> 2) + 4 * hf) * 128] = S[kt][i];
}

__device__ __forceinline__ void hgrn_sample_item(int layer, int j, int item, LAS float* L) {
    const KPtr p = kparams();
    const int tid = opaque_tid(), lane = tid & 63, wave = tid >> 6;
    const int s = item >> 3, h = item & 7;
    float* PROJ = (float*)(p->ws + WS_PROJ);
    const float* lbs = (const float*)(p->ws + WS_LBS) + layer * 1024;
    LAS float* qe = L;
    LAS float* kd = L + 512;
    LAS float* egl = L + 1024;
    LAS float* vv = L + 1152;
    LAS float* Ap = L + 1664;
    LAS float* part = L + 1728;
    const size_t r0 = (size_t)(MP + 4 * s);
    if (tid < 128) {
        const int k = tid; const float lb = lbs[h * 128 + k];
        float sq[4], kk[4], Gt[4]; float Gc = 0.f;
#pragma unroll
        for (int t = 0; t < 4; ++t) { const float* pr = PROJ + (r0 + t) * NPROJ + 256 * h + k;
            const float q = pr[0], fp = pr[128]; const float f = lb + (1.f - lb) * sigmoidf_(fp);
            Gc += __logf(f); Gt[t] = Gc; sq[t] = siluf_(q); kk[t] = 1.f - f; }
#pragma unroll
        for (int t = 0; t < 4; ++t) { qe[t * 128 + k] = sq[t] * __expf(Gt[t]); kd[t * 128 + k] = kk[t] * __expf(Gt[3] - Gt[t]); }
        egl[k] = __expf(Gt[3]);
#pragma unroll
        for (int t = 0; t < 4; ++t)
#pragma unroll
            for (int u = 0; u < 4; ++u) { float a = (u <= t) ? sq[t] * kk[u] * __expf(Gt[t] - Gt[u]) : 0.f; a = wave_sum(a); if (lane == 0) Ap[wave * 16 + t * 4 + u] = a; }
    } else if (tid < 256) {
        const int v = tid - 128;
#pragma unroll
        for (int t = 0; t < 4; ++t) vv[t * 128 + v] = PROJ[(r0 + t) * NPROJ + 2048 + 256 * h + v];
    }
    __syncthreads();
    {
        const int kg = tid >> 5, vg = tid & 31;
        const float* S0 = p->state_hgrn + ((size_t)((j * 128 + s) * 8 + h)) * 16384;
        float* S1 = p->out + O_HGS + ((size_t)((j * 128 + s) * 8 + h)) * 16384;
        f32x4 po[4];
#pragma unroll
        for (int t = 0; t < 4; ++t) po[t] = (f32x4){0.f, 0.f, 0.f, 0.f};
        f32x4 v4[4];
#pragma unroll
        for (int t = 0; t < 4; ++t) v4[t] = *(const LAS f32x4*)(vv + t * 128 + 4 * vg);
#pragma unroll
        for (int i = 0; i < 8; ++i) {
            const int k = 8 * kg + i;
            const f32x4 s0 = *(const f32x4*)(S0 + (size_t)k * 128 + 4 * vg);
            f32x4 sn = s0 * egl[k];
#pragma unroll
            for (int t = 0; t < 4; ++t) { sn += v4[t] * kd[t * 128 + k]; po[t] += s0 * qe[t * 128 + k]; }
            *(f32x4*)(S1 + (size_t)k * 128 + 4 * vg) = sn;
        }
#pragma unroll
        for (int t = 0; t < 4; ++t) *(LAS f32x4*)(part + (kg * 4 + t) * 128 + 4 * vg) = po[t];
    }
    __syncthreads();
    {
        const int t = tid >> 7, v = tid & 127;
        float o = 0.f;
#pragma unroll
        for (int kg = 0; kg < 16; ++kg) o += part[(kg * 4 + t) * 128 + v];
#pragma unroll
        for (int u = 0; u < 4; ++u) if (u <= t) o += (Ap[t * 4 + u] + Ap[16 + t * 4 + u]) * vv[u * 128 + v];
        PROJ[(r0 + t) * NPROJ + 256 * h + v] = o;
    }
    __syncthreads();
}

__device__ __forceinline__ void phase_hgrn_rec(int layer, int j, LAS unsigned char* lds, int G) {
    const KPtr p = kparams();
    const int tid = opaque_tid(), lane = tid & 63, wave = tid >> 6;
    for (int item = opaque_bid(); item < 1024; item += G) hgrn_sample_item(layer, j, item, (LAS float*)lds);
    if (wave == 0) for (int item = opaque_bid(); item < 256; item += G) hgrn_prompt_item(j, item, lane);
}

__device__ __forceinline__ void phase_hgrn_y(int j, int G) {
    const KPtr p = kparams();
    const int tid = opaque_tid(), lane = tid & 63, wave = tid >> 6;
    const int gw = opaque_bid() * NWAVES + wave, NGW = G * NWAVES;
    const float* PROJ = (const float*)(p->ws + WS_PROJ);
    bf16* YB = (bf16*)(p->ws + WS_HB);
    const float* og = p->hgrn_onorm_g + (size_t)j * 1024;
    for (int r = gw; r < M; r += NGW) {
        const float* pr = PROJ + (size_t)r * NPROJ;
#pragma unroll
        for (int jj = 0; jj < 4; ++jj) {
            const int e = 4 * lane + 256 * jj, h = e >> 7, v = e & 127;
            const f32x4 o = *(const f32x4*)(pr + 256 * h + v), z = *(const f32x4*)(pr + 2048 + 256 * h + 128 + v), g = *(const f32x4*)(og + e);
            float ss = (o.x * o.x + o.y * o.y) + (o.z * o.z + o.w * o.w);
#pragma unroll
            for (int m = 1; m < 32; m <<= 1) ss += __shfl_xor(ss, m);
            const float rs = 1.f / sqrtf(ss * (1.f / 128.f) + EPS);
            v2u w; w.x = pk2(o.x * rs * g.x * siluf_(z.x), o.y * rs * g.y * siluf_(z.y)); w.y = pk2(o.z * rs * g.z * siluf_(z.z), o.w * rs * g.w * siluf_(z.w));
            *(v2u*)(YB + (size_t)r * D + e) = w;
        }
    }
}

__device__ __forceinline__ void phase_ada_gemm(LAS unsigned char* lds, int G) {
    const KPtr p = kparams(); unsigned char* ws = p->ws;
    pg8::Gemm g{(const pg8::bf16_t*)(ws + WS_ACT), (const pg8::bf16_t*)(ws + WS_WADA), 256, MODLD, 1024}; pg8::StaticOrder S; S.init(256, MODLD, G, opaque_bid());
    EpiStoreF32 E{(float*)(ws + WS_MOD), MODLD, p->b_ada};
    pg8::gemm_phase<EpiStoreF32, pg8::StaticOrder, true, true>(lds, g, S, E);
}
__device__ __forceinline__ void phase_in_gemm(int layer, LAS unsigned char* lds, int G) {
    const KPtr p = kparams(); unsigned char* ws = p->ws;
    const int j = layer >> 1;
    const bf16* W = (const bf16*)(ws + ((layer & 1) ? WS_WHIN : WS_WCIN)) + (size_t)j * 4096 * 1024;
    pg8::Gemm g{(const pg8::bf16_t*)(ws + WS_HB), W, M, NPROJ, 1024}; pg8::StaticOrder S; S.init(M, NPROJ, G, opaque_bid());
    EpiStoreF32 E{(float*)(ws + WS_PROJ), NPROJ, nullptr};
    pg8::gemm_phase<EpiStoreF32, pg8::StaticOrder, true, true>(lds, g, S, E);
}
__device__ __forceinline__ void phase_out_gemm(int layer, LAS unsigned char* lds, int G) {
    const KPtr p = kparams(); unsigned char* ws = p->ws;
    const int j = layer >> 1;
    float* X = p->out + O_Y;
    const bf16* W = (const bf16*)(ws + ((layer & 1) ? WS_WHOUT : WS_WCOUT)) + (size_t)j * 1024 * 1024;
    pg8::Gemm g{(const pg8::bf16_t*)(ws + WS_HB), W, M, D, 1024}; pg8::StaticOrder S; S.init(M, D, G, opaque_bid());
    EpiResid E{layer == 0 ? p->x_prompt : X, layer == 0 ? p->x_sample : X + (size_t)MP * D, X, (const float*)(ws + WS_MOD) + layer * 3072 + 2048};
    pg8::gemm_phase<EpiResid, pg8::StaticOrder, true, true>(lds, g, S, E);
}

__global__ void __launch_bounds__(NTHREADS, 2) fwd_megakernel(Params p_unused) {
    extern __shared__ __attribute__((aligned(16))) unsigned char lds_raw[];
    LAS unsigned char* lds = (LAS unsigned char*)lds_raw;
    cg::grid_group grid = cg::this_grid();
    const int G = gridDim.x;

    phase_prologue(lds, G);
    grid.sync();
    phase_ada_gemm(lds, G);
    grid.sync();
#pragma unroll 1
    for (int layer = 0; layer < 4; ++layer) {
        const int j = layer >> 1; const bool is_conv = (layer & 1) == 0;
        phase_norm(layer, G);
        grid.sync();
        phase_in_gemm(layer, lds, G);
        grid.sync();
        if (is_conv) { phase_conv_y(j, G); }
        else {
            phase_hgrn_prep(layer, G);
            grid.sync();
            phase_hgrn_rec(layer, j, lds, G);
            grid.sync();
            phase_hgrn_y(j, G);
        }
        grid.sync();
        phase_out_gemm(layer, lds, G);
        grid.sync();
    }
    phase_final(G);
}

extern "C" void kernel_launch(void* const* d_in, const int* in_sizes, int n_in, void* d_out, int out_size, void* d_ws, size_t ws_size, hipStream_t stream) {
    static int grid_blocks = 0;
    if (grid_blocks == 0) {
        if (n_in != 17 || ws_size < WS_END) { fprintf(stderr, "kernel_launch: unexpected n_in %d or ws_size %zu (< %zu)\n", n_in, ws_size, (size_t)WS_END); grid_blocks = -1; return; }
        int dev = 0, cus = 0, per_cu = 0;
        hipGetDevice(&dev);
        hipDeviceGetAttribute(&cus, hipDeviceAttributeMultiprocessorCount, dev);
        if (hipFuncSetAttribute((const void*)fwd_megakernel, hipFuncAttributeMaxDynamicSharedMemorySize, LDS_BYTES) != hipSuccess) { fprintf(stderr, "kernel_launch: hipFuncSetAttribute failed\n"); grid_blocks = -1; return; }
        hipOccupancyMaxActiveBlocksPerMultiprocessor(&per_cu, (const void*)fwd_megakernel, NTHREADS, LDS_BYTES);
        if (per_cu < 1) { fprintf(stderr, "kernel_launch: occupancy query returned %d\n", per_cu); per_cu = 1; }
        grid_blocks = cus * per_cu;
    }
    if (grid_blocks < 0) return;
    Params p{};
    p.x_prompt = (const float*)d_in[0]; p.x_sample = (const float*)d_in[1]; p.state_conv = (const float*)d_in[2]; p.state_hgrn = (const float*)d_in[3];
    p.c_prompt = (const float*)d_in[4]; p.c_sample = (const float*)d_in[5]; p.norm_g = (const float*)d_in[6]; p.w_ada = (const float*)d_in[7]; p.b_ada = (const float*)d_in[8];
    p.conv_w_in = (const float*)d_in[9]; p.conv_w = (const float*)d_in[10]; p.conv_w_out = (const float*)d_in[11]; p.hgrn_w_in = (const float*)d_in[12];
    p.hgrn_lb = (const float*)d_in[13]; p.hgrn_onorm_g = (const float*)d_in[14]; p.hgrn_w_out = (const float*)d_in[15]; p.final_norm_g = (const float*)d_in[16];
    p.out = (float*)d_out; p.ws = (unsigned char*)d_ws;
    void* args[] = {&p};
    hipError_t e = hipLaunchCooperativeKernel((const void*)fwd_megakernel, dim3(grid_blocks), dim3(NTHREADS), args, LDS_BYTES, stream);
    if (e != hipSuccess) fprintf(stderr, "cooperative launch failed: %s (grid %d)\n", hipGetErrorString(e), grid_blocks);
}
```

```cpp
#include <hip/hip_runtime.h>
#include <hip/hip_cooperative_groups.h>
#include <cstdio>
#include <cstdint>
namespace cg = cooperative_groups;
__device__ __forceinline__ int opaque_tid() { int t = (int)threadIdx.x; asm volatile("" : "+v"(t)); return t; }
__device__ __forceinline__ int opaque_bid() { int b = (int)blockIdx.x; asm volatile("" : "+s"(b)); return b; }
__device__ __forceinline__ int opaque_s(int x) { asm volatile("" : "+s"(x)); return x; }
namespace pg8 {
#define PG8_LAS __attribute__((address_space(3)))
typedef unsigned short bf16_t;
typedef short bf16x8 __attribute__((ext_vector_type(8)));
typedef float f32x4 __attribute__((ext_vector_type(4)));
typedef unsigned u32x4 __attribute__((ext_vector_type(4)));
constexpr int BM = 256, BK = 64, HALF = 128, HTB = HALF * BK * 2  , STAGE_BYTES = 8 * HTB, NXCD = 8, WGM = 8;

__host__ __device__ __forceinline__ int lds_byte(int r, int c) { const int st = (r >> 4) * 2 + (c >> 5), rr = r & 15, cc = c & 31, ob = rr * 64 + cc * 2; return st * 1024 + (ob ^ (((ob >> 9) & 1) << 5)); }
__host__ __device__ __forceinline__ void stage_rc(int b, int& R, int& C) { const int st = b / 1024, sb = b % 1024, swz = sb ^ (((sb >> 9) & 1) << 5); R = (st >> 1) * 16 + swz / 64; C = (st & 1) * 32 + (swz % 64) / 2; }
__host__ __device__ __forceinline__ int perm32(int rho) { const int n = rho >> 4, i = rho & 15; return 8 * (i >> 2) + 4 * n + (i & 3); }

struct Unit { int pm, pn; };
struct Gemm { const bf16_t* A; const bf16_t* Bt; int M, N, K; };

struct StaticOrder {
    int nM, nN, nwg, G, c;
    __host__ __device__ void init(int M, int N, int G_, int c_) { nM = M / BM; nN = N / BM; nwg = nM * nN; G = G_; c = c_; }
    __host__ __device__ bool next(int i, Unit& u) const {
        const long L = (long)i * G + c; if (L >= nwg) return false;
        int wgid = (int)L; { const int q = nwg / NXCD, r = nwg % NXCD, xcd = wgid % NXCD, off = wgid / NXCD; wgid = (xcd < r ? xcd * (q + 1) : r * (q + 1) + (xcd - r) * q) + off; }
        const int nig = WGM * nN, gid = wgid / nig, fm = gid * WGM, gsz = (nM - fm) < WGM ? (nM - fm) : WGM;
        u.pm = fm + ((wgid % nig) % gsz); u.pn = (wgid % nig) / gsz; return true;
    }
    __device__ __forceinline__ void a_ready(const Unit&) const {}
    __device__ __forceinline__ void done(const Unit&) const {}
};

__device__ __forceinline__ unsigned cvt_pk_bf16(float lo, float hi) { unsigned r; asm volatile("v_cvt_pk_bf16_f32 %0, %1, %2" : "=v"(r) : "v"(lo), "v"(hi)); return r; }
template <class Epi, class Sched, bool ALIGN_EPI = false, bool SP2 = false>
__device__ __forceinline__ void gemm_phase(PG8_LAS unsigned char* lds, const Gemm g, const Sched& S, const Epi& E) {
    const int tid = opaque_tid(), wid = __builtin_amdgcn_readfirstlane(tid >> 6), lane = tid & 63, wr = wid >> 2, wc = wid & 3, fr = lane & 15, fq = lane >> 4;
    const int K = g.K, nt = K / BK;
    unsigned voffA[2], voffB[2];
#pragma unroll
    for (int i = 0; i < 2; ++i) { int R, C; stage_rc(tid * 16 + i * 8192, R, C); const int Rb = Epi::PERM ? ((R & ~31) + perm32(R & 31)) : R;
        voffA[i] = (unsigned)(R * K + C) * 2u; voffB[i] = (unsigned)(Rb * K + C) * 2u; }
    const size_t kstep = (size_t)(BK * 2);
    const size_t hstep = (size_t)HALF * K * 2;
    const size_t tstep = 2 * hstep;
    const unsigned ldsw = (unsigned)wid * 1024u;
    const int aoff = lds_byte(wr * 64 + fr, fq * 8), boff = lds_byte(wc * 32 + fr, fq * 8);
#define PG8_SA(b, h) (((b) * 2 + (h)) * HTB)
#define PG8_SB(b, h) ((4 + (b) * 2 + (h)) * HTB)
#define PG8_STAGE(bufoff, gbase, voff) do { _Pragma("unroll") for (int _i = 0; _i < 2; ++_i) \
        __builtin_amdgcn_global_load_lds((const unsigned*)((const char*)(gbase) + (voff)[_i]), (PG8_LAS unsigned*)(lds + (bufoff) + ldsw + _i * 8192), 16, 0, 0); } while (0)
#define PG8_LDA(dst, b, h) do { _Pragma("unroll") for (int m = 0; m < 4; ++m) _Pragma("unroll") for (int k = 0; k < 2; ++k) dst[m][k] = *(const PG8_LAS bf16x8*)(lds + PG8_SA(b, h) + aoff + m * 2048 + k * 1024); } while (0)
#define PG8_LDB(dst, b, h) do { _Pragma("unroll") for (int n = 0; n < 2; ++n) _Pragma("unroll") for (int k = 0; k < 2; ++k) dst[n][k] = *(const PG8_LAS bf16x8*)(lds + PG8_SB(b, h) + boff + n * 2048 + k * 1024); } while (0)
#define PG8_MMA(ai, bj, At, Bt) do { __builtin_amdgcn_s_setprio(1); _Pragma("unroll") for (int m = 0; m < 4; ++m) _Pragma("unroll") for (int n = 0; n < 2; ++n) _Pragma("unroll") for (int k = 0; k < 2; ++k) \
        acc[ai][bj][m][n] = __builtin_amdgcn_mfma_f32_16x16x32_bf16(Bt[n][k], At[m][k], acc[ai][bj][m][n], 0, 0, 0); __builtin_amdgcn_s_setprio(0); } while (0)
#define PG8_WAIT_V(n) asm volatile("s_waitcnt vmcnt(" #n ")" ::: "memory")
#define PG8_WAIT_L(n) asm volatile("s_waitcnt lgkmcnt(" #n ")" ::: "memory")
#define PG8_BAR __builtin_amdgcn_s_barrier()
#define PG8_SCHED __builtin_amdgcn_sched_barrier(0)
    Unit cur, nxt; int ui = 0;
    if (!S.next(0, cur)) return;
    f32x4 acc[2][2][4][2];
#pragma unroll
    for (int a = 0; a < 2; ++a)
#pragma unroll
        for (int b = 0; b < 2; ++b)
#pragma unroll
            for (int m = 0; m < 4; ++m)
#pragma unroll
                for (int n = 0; n < 2; ++n) acc[a][b][m][n] = (f32x4){0.f, 0.f, 0.f, 0.f};
    bf16x8 At[4][2], B0[2][2], B1[2][2];
    const char* cA = (const char*)g.A + (size_t)cur.pm * tstep; const char* cB = (const char*)g.Bt + (size_t)cur.pn * tstep;
    S.a_ready(cur);
    if constexpr (SP2) {
        PG8_STAGE(PG8_SB(0, 0), cB, voffB); PG8_STAGE(PG8_SB(0, 1), cB + hstep, voffB); PG8_STAGE(PG8_SA(0, 0), cA, voffA); PG8_STAGE(PG8_SA(0, 1), cA + hstep, voffA);
        if (wr == 1) PG8_BAR;
        PG8_WAIT_V(2); PG8_BAR;
        PG8_STAGE(PG8_SB(1, 0), cB + kstep, voffB); PG8_STAGE(PG8_SA(1, 0), cA + kstep, voffA); PG8_STAGE(PG8_SB(1, 1), cB + hstep + kstep, voffB);
        PG8_WAIT_V(6); PG8_BAR;
    } else {
        PG8_STAGE(PG8_SB(0, 0), cB, voffB); PG8_STAGE(PG8_SA(0, 0), cA, voffA); PG8_STAGE(PG8_SB(0, 1), cB + hstep, voffB); PG8_STAGE(PG8_SA(0, 1), cA + hstep, voffA);
        if (wr == 1) PG8_BAR;
        PG8_WAIT_V(4); PG8_BAR;
        PG8_STAGE(PG8_SB(1, 0), cB + kstep, voffB); PG8_STAGE(PG8_SA(1, 0), cA + kstep, voffA); PG8_STAGE(PG8_SB(1, 1), cB + hstep + kstep, voffB);
        PG8_WAIT_V(6); PG8_BAR;
    }
    for (;;) {
        const bool has_next = S.next(ui + 1, nxt);
        const char* nA = has_next ? (const char*)g.A + (size_t)nxt.pm * tstep : cA; const char* nB = has_next ? (const char*)g.Bt + (size_t)nxt.pn * tstep : cB;
        for (int t = 0; t < nt; t += 2) {
            const bool last = (t == nt - 2);
            const char* a1 = cA + (size_t)(t + 1) * kstep;
            const char* a2 = last ? nA : cA + (size_t)(t + 2) * kstep; const char* b2 = last ? nB : cB + (size_t)(t + 2) * kstep;
            const char* a3 = a2 + kstep; const char* b3 = b2 + kstep;
            if (last && has_next) S.a_ready(nxt);
            if constexpr (SP2) {
            PG8_LDB(B0, 0, 0); PG8_LDB(B1, 0, 1); PG8_SCHED; PG8_LDA(At, 0, 0); PG8_STAGE(PG8_SA(1, 1), a1 + hstep, voffA);
            PG8_WAIT_V(8); PG8_WAIT_L(0); PG8_BAR; PG8_MMA(0, 0, At, B0); PG8_MMA(0, 1, At, B1); PG8_BAR; PG8_SCHED;
            PG8_LDA(At, 0, 1); PG8_STAGE(PG8_SB(0, 0), b2, voffB); PG8_STAGE(PG8_SB(0, 1), b2 + hstep, voffB); PG8_STAGE(PG8_SA(0, 0), a2, voffA);
            PG8_WAIT_V(8); PG8_WAIT_L(0); PG8_BAR; PG8_MMA(1, 0, At, B0); PG8_MMA(1, 1, At, B1); PG8_BAR; PG8_SCHED;
            PG8_LDB(B0, 1, 0); PG8_LDB(B1, 1, 1); PG8_SCHED; PG8_LDA(At, 1, 0); PG8_STAGE(PG8_SA(0, 1), a2 + hstep, voffA);
            PG8_WAIT_V(8); PG8_WAIT_L(0); PG8_BAR; PG8_MMA(0, 0, At, B0); PG8_MMA(0, 1, At, B1); PG8_BAR; PG8_SCHED;
            PG8_LDA(At, 1, 1); PG8_STAGE(PG8_SB(1, 0), b3, voffB); PG8_STAGE(PG8_SB(1, 1), b3 + hstep, voffB); PG8_STAGE(PG8_SA(1, 0), a3, voffA);
            PG8_WAIT_V(8); PG8_WAIT_L(0); PG8_BAR; PG8_MMA(1, 0, At, B0); PG8_MMA(1, 1, At, B1); PG8_BAR; PG8_SCHED;
            } else {
            PG8_LDB(B0, 0, 0); PG8_SCHED; PG8_LDA(At, 0, 0); PG8_STAGE(PG8_SA(1, 1), a1 + hstep, voffA);
            PG8_WAIT_L(8); PG8_BAR; PG8_WAIT_L(0); PG8_MMA(0, 0, At, B0); PG8_BAR; PG8_SCHED;
            PG8_LDB(B1, 0, 1); PG8_STAGE(PG8_SB(0, 0), b2, voffB);
            PG8_BAR; PG8_WAIT_L(0); PG8_MMA(0, 1, At, B1); PG8_BAR;
            PG8_LDA(At, 0, 1); PG8_STAGE(PG8_SA(0, 0), a2, voffA);
            PG8_BAR; PG8_WAIT_L(0); PG8_MMA(1, 0, At, B0); PG8_BAR; PG8_SCHED;
            PG8_STAGE(PG8_SB(0, 1), b2 + hstep, voffB);
            PG8_WAIT_V(6); PG8_BAR; PG8_MMA(1, 1, At, B1); PG8_BAR;
            PG8_LDB(B0, 1, 0); PG8_SCHED; PG8_LDA(At, 1, 0); PG8_STAGE(PG8_SA(0, 1), a2 + hstep, voffA);
            PG8_WAIT_L(8); PG8_BAR; PG8_WAIT_L(0); PG8_MMA(0, 0, At, B0); PG8_BAR; PG8_SCHED;
            PG8_LDB(B1, 1, 1); PG8_STAGE(PG8_SB(1, 0), b3, voffB);
            PG8_BAR; PG8_WAIT_L(0); PG8_MMA(0, 1, At, B1); PG8_BAR;
            PG8_LDA(At, 1, 1); PG8_STAGE(PG8_SA(1, 0), a3, voffA);
            PG8_BAR; PG8_WAIT_L(0); PG8_MMA(1, 0, At, B0); PG8_BAR; PG8_SCHED;
            PG8_STAGE(PG8_SB(1, 1), b3 + hstep, voffB);
            PG8_WAIT_V(6); PG8_BAR; PG8_MMA(1, 1, At, B1); PG8_BAR;
            }
        }
        if constexpr (ALIGN_EPI) { if (wr == 0) PG8_BAR; }
        if constexpr (!Epi::AFTER_DRAIN) { E(acc, cur, wr, wc, fr, fq); S.done(cur); }
        if (!has_next) break;
#pragma unroll
        for (int a = 0; a < 2; ++a)
#pragma unroll
            for (int b = 0; b < 2; ++b)
#pragma unroll
                for (int m = 0; m < 4; ++m)
#pragma unroll
                    for (int n = 0; n < 2; ++n) acc[a][b][m][n] = (f32x4){0.f, 0.f, 0.f, 0.f};
        cur = nxt; cA = nA; cB = nB; ++ui;
        if constexpr (ALIGN_EPI) { if (wr == 1) PG8_BAR; }
    }
    PG8_WAIT_V(0);
    if constexpr (!ALIGN_EPI) { if (wr == 0) PG8_BAR; }
    PG8_BAR;
    if constexpr (Epi::AFTER_DRAIN) { E.fused(acc, cur, wr, wc, fr, fq, lds, wid, lane); S.done(cur); }
#undef PG8_SA
#undef PG8_SB
#undef PG8_STAGE
#undef PG8_LDA
#undef PG8_LDB
#undef PG8_MMA
#undef PG8_WAIT_V
#undef PG8_WAIT_L
#undef PG8_BAR
#undef PG8_SCHED
}
}

constexpr int NWAVES = 8, NTHREADS = 512;
constexpr int D = 1024, MP = 16384, MS = 512, M = MP + MS, NPROJ = 4096;
constexpr int MODLD = 12288;
constexpr float EPS = 1e-6f;
constexpr size_t O_Y = 0, O_CONVP = 17301504, O_HGP = 17334272, O_CONVS = 19431424, O_HGS = 19955712;
constexpr size_t MiB = 1u << 20;
constexpr size_t WS_WCIN = 1 * MiB, WS_WHIN = 17 * MiB, WS_WCOUT = 33 * MiB, WS_WHOUT = 37 * MiB, WS_MOD = 41 * MiB, WS_ACT = 53 * MiB,
                 WS_LBS = 54 * MiB, WS_DEC = 55 * MiB, WS_HB = 57 * MiB, WS_FRQ = 90 * MiB, WS_FRK = 122 * MiB, WS_FRKT = 154 * MiB, WS_FRV = 186 * MiB,
                 WS_PROJ = 218 * MiB, WS_WADA = WS_PROJ, WS_U = WS_PROJ, WS_GB = WS_PROJ + 33 * MiB, WS_END = 482 * MiB;
constexpr int LDS_BYTES = 147456;

#define LAS __attribute__((address_space(3)))
typedef unsigned short bf16;
typedef unsigned v4u __attribute__((ext_vector_type(4)));
typedef unsigned v2u __attribute__((ext_vector_type(2)));
typedef float f32x4 __attribute__((ext_vector_type(4)));
typedef float f32x2 __attribute__((ext_vector_type(2)));
typedef float f32x16 __attribute__((ext_vector_type(16)));
typedef short bf16x8 __attribute__((ext_vector_type(8)));
typedef __bf16 bf16x2n __attribute__((ext_vector_type(2)));
#define LDS_WAIT() asm volatile("s_waitcnt lgkmcnt(0)" ::: "memory")

__device__ __forceinline__ unsigned pk2(float lo, float hi) { f32x2 v = {lo, hi}; return __builtin_bit_cast(unsigned, __builtin_convertvector(v, bf16x2n)); }
__device__ __forceinline__ unsigned short f2bf(float f) { return (unsigned short)(pk2(f, 0.f) & 0xffffu); }
__device__ __forceinline__ float sigmoidf_(float x) { return 1.f / (1.f + __expf(-x)); }
__device__ __forceinline__ float siluf_(float x) { return x * sigmoidf_(x); }
__device__ __forceinline__ float wave_sum(float v) {
#pragma unroll
    for (int o = 1; o < 64; o <<= 1) v += __shfl_xor(v, o);
    return v;
}
__device__ __forceinline__ int mod_row(int r) { return r < MP ? (r >> 11) : 8 + ((r - MP) >> 2); }

struct Params {
    const float* x_prompt; const float* x_sample; const float* state_conv; const float* state_hgrn;
    const float* c_prompt; const float* c_sample; const float* norm_g; const float* w_ada; const float* b_ada;
    const float* conv_w_in; const float* conv_w; const float* conv_w_out; const float* hgrn_w_in;
    const float* hgrn_lb; const float* hgrn_onorm_g; const float* hgrn_w_out; const float* final_norm_g;
    float* out; unsigned char* ws;
};


typedef const Params __attribute__((address_space(4))) * KPtr;
__device__ __forceinline__ KPtr kparams() { KPtr q = (KPtr)__builtin_amdgcn_kernarg_segment_ptr(); asm volatile("" : "+s"(q)); return q; }
#define KP(field) (kparams()->field)

struct EpiStoreF32 {
    static constexpr bool PERM = false, AFTER_DRAIN = false;
    float* C; int ldc; const float* bias;
    __device__ __forceinline__ void operator()(const f32x4 (&acc)[2][2][4][2], const pg8::Unit& u, int wr, int wc, int fr, int fq) const {
        const int row0 = u.pm * 256 + wr * 64 + fr, col0 = u.pn * 256 + wc * 32 + 4 * fq;
        f32x4 bv[2][2];
#pragma unroll
        for (int bj = 0; bj < 2; ++bj)
#pragma unroll
            for (int n = 0; n < 2; ++n) bv[bj][n] = bias ? *(const f32x4*)(bias + col0 + bj * 128 + n * 16) : (f32x4){0.f, 0.f, 0.f, 0.f};
#pragma unroll
        for (int ai = 0; ai < 2; ++ai)
#pragma unroll
            for (int m = 0; m < 4; ++m) { float* rowp = C + (size_t)(row0 + ai * 128 + m * 16) * ldc + col0;
#pragma unroll
                for (int bj = 0; bj < 2; ++bj)
#pragma unroll
                    for (int n = 0; n < 2; ++n) *(f32x4*)(rowp + bj * 128 + n * 16) = acc[ai][bj][m][n] + bv[bj][n]; }
    }
};
struct EpiResid {
    static constexpr bool PERM = false, AFTER_DRAIN = false;
    const float* xp; const float* xs;
    float* X; const float* gate;
    __device__ __forceinline__ void operator()(const f32x4 (&acc)[2][2][4][2], const pg8::Unit& u, int wr, int wc, int fr, int fq) const {
        const int row0 = u.pm * 256 + wr * 64 + fr, col0 = u.pn * 256 + wc * 32 + 4 * fq;
#pragma unroll
        for (int ai = 0; ai < 2; ++ai)
#pragma unroll
            for (int m = 0; m < 4; ++m) {
                const int r = row0 + ai * 128 + m * 16;
                const float* xo = (r < MP) ? xp + (size_t)r * D : xs + (size_t)(r - MP) * D;
                const float* gp = gate + (size_t)mod_row(r) * MODLD;
                float* xn = X + (size_t)r * D;
#pragma unroll
                for (int bj = 0; bj < 2; ++bj)
#pragma unroll
                    for (int n = 0; n < 2; ++n) { const int c = col0 + bj * 128 + n * 16;
                        const f32x4 xv = *(const f32x4*)(xo + c), gv = *(const f32x4*)(gp + c);
                        *(f32x4*)(xn + c) = xv + gv * acc[ai][bj][m][n]; } }
    }
};


__device__ __forceinline__ f32x4 silu4(f32x4 z) { return (f32x4){siluf_(z.x), siluf_(z.y), siluf_(z.z), siluf_(z.w)}; }
struct EpiConv {
    static constexpr bool PERM = false, AFTER_DRAIN = false;
    bf16* U; bf16* GB; float* convp; float* convs;
    __device__ __forceinline__ void operator()(const f32x4 (&acc)[2][2][4][2], const pg8::Unit& u, int wr, int wc, int fr, int fq) const {
        const int row0 = u.pm * 256 + wr * 64 + fr, e0 = u.pn * 64 + wc * 16 + 4 * fq;
#pragma unroll
        for (int ai = 0; ai < 2; ++ai)
#pragma unroll
            for (int m = 0; m < 4; ++m) {
                const int r = row0 + ai * 128 + m * 16;
                const f32x4 u4 = acc[ai][0][m][1] * acc[ai][1][m][0];
                const f32x4 g4 = acc[ai][0][m][0] * silu4(acc[ai][1][m][1]);
                v2u w; w.x = pk2(u4.x, u4.y); w.y = pk2(u4.z, u4.w); *(v2u*)(U + (size_t)r * D + e0) = w;
                w.x = pk2(g4.x, g4.y); w.y = pk2(g4.z, g4.w); *(v2u*)(GB + (size_t)r * D + e0) = w;
                if (r < MP) { const int t = r & 2047; if (t >= 2046) *(f32x4*)(convp + ((size_t)(r >> 11) * 2 + (t - 2046)) * 1024 + e0) = u4; }
                else { const int t = (r - MP) & 3; if (t >= 2) *(f32x4*)(convs + ((size_t)((r - MP) >> 2) * 2 + (t - 2)) * 1024 + e0) = u4; }
            }
    }
};

__device__ __forceinline__ int src_col(int mode, int np) {
    if (mode == 0) return np;
    if (mode == 1) { const int pn = np >> 8, cl = np & 255, bj = cl >> 7, wc = (cl >> 5) & 3, n = (cl >> 4) & 1, rest = cl & 15;
        return (2 * bj + n) * 1024 + 64 * pn + 16 * wc + rest; }
    const int pn = np >> 8, bj = (np >> 7) & 1, idx = np & 127;
    return pn < 8 ? bj * 1024 + 128 * pn + idx : 2048 + bj * 1024 + 128 * (pn - 8) + idx;
}
__device__ __forceinline__ void transpose_item(const float* W, int N, bf16* WT, int row_off, int mode, LAS float* scr, int item, int lane) {
    const int nblk = N / 32, kb = item / nblk, nb = item % nblk, k0 = 64 * kb, n0 = 32 * nb;
    const int sc = src_col(mode, n0 + (lane & 31));
#pragma unroll 8
    for (int i = 0; i < 32; ++i) { const int kk = 2 * i + (lane >> 5); scr[kk * 33 + (lane & 31)] = W[(size_t)(k0 + kk) * N + sc]; }
    LDS_WAIT(); asm volatile("" ::: "memory");
    const int c = lane & 7;
#pragma unroll
    for (int j = 0; j < 4; ++j) { const int n = (lane >> 3) + 8 * j; const LAS float* s = scr + (8 * c) * 33 + n;
        v4u o; o.x = pk2(s[0 * 33], s[1 * 33]); o.y = pk2(s[2 * 33], s[3 * 33]); o.z = pk2(s[4 * 33], s[5 * 33]); o.w = pk2(s[6 * 33], s[7 * 33]);
        *(v4u*)(WT + (size_t)(row_off + n0 + n) * 1024 + k0 + 8 * c) = o; }
    LDS_WAIT(); asm volatile("" ::: "memory");
}

__device__ __forceinline__ void phase_prologue(LAS unsigned char* lds, int G) {
    const KPtr p = kparams();
    const int tid = opaque_tid(), lane = tid & 63, wave = tid >> 6;
    const int gw = opaque_bid() * NWAVES + wave, NGW = G * NWAVES;
    LAS float* scr = (LAS float*)(lds + wave * 16384);
    unsigned char* ws = p->ws;
    constexpr int I_IN = 16 * 128, I_OUT = 16 * 32, I_ADA = 16 * 96;
    constexpr int NITEMS = 4 * I_IN + 4 * I_OUT + 4 * I_ADA;
    for (int it = gw; it < NITEMS; it += NGW) {
        int r = it;
        if (r < 4 * I_ADA) { const int l = r / I_ADA; transpose_item(p->w_ada + (size_t)l * 1024 * 3072, 3072, (bf16*)(ws + WS_WADA), l * 3072, 0, scr, r % I_ADA, lane); continue; } r -= 4 * I_ADA;
        if (r < 2 * I_IN) { const int j = r / I_IN; transpose_item(p->conv_w_in + (size_t)j * 1024 * 4096, 4096, (bf16*)(ws + WS_WCIN) + (size_t)j * 4096 * 1024, 0, 1, scr, r % I_IN, lane); continue; } r -= 2 * I_IN;
        if (r < 2 * I_IN) { const int j = r / I_IN; transpose_item(p->hgrn_w_in + (size_t)j * 1024 * 4096, 4096, (bf16*)(ws + WS_WHIN) + (size_t)j * 4096 * 1024, 0, 2, scr, r % I_IN, lane); continue; } r -= 2 * I_IN;
        if (r < 2 * I_OUT) { const int j = r / I_OUT; transpose_item(p->conv_w_out + (size_t)j * 1024 * 1024, 1024, (bf16*)(ws + WS_WCOUT) + (size_t)j * 1024 * 1024, 0, 0, scr, r % I_OUT, lane); continue; } r -= 2 * I_OUT;
        { const int j = r / I_OUT; transpose_item(p->hgrn_w_out + (size_t)j * 1024 * 1024, 1024, (bf16*)(ws + WS_WHOUT) + (size_t)j * 1024 * 1024, 0, 0, scr, r % I_OUT, lane); }
    }
    const int gt = opaque_bid() * NTHREADS + tid, NGT = G * NTHREADS;
    bf16* act = (bf16*)(ws + WS_ACT);
    for (int i = gt; i < 256 * 1024; i += NGT) { const int r = i >> 10, d = i & 1023;
        float v = 0.f; if (r < 8) v = siluf_(p->c_prompt[r * 1024 + d]); else if (r < 136) v = siluf_(p->c_sample[(r - 8) * 1024 + d]);
        act[i] = f2bf(v); }
    float* lbs = (float*)(ws + WS_LBS);
    for (int e = gt; e < 1024; e += NGT) {
        const float a0 = p->hgrn_lb[e], a1 = p->hgrn_lb[1024 + e], a2 = p->hgrn_lb[2048 + e], a3 = p->hgrn_lb[3072 + e];
        const float mx = fmaxf(fmaxf(a0, a1), fmaxf(a2, a3));
        const float e0 = __expf(a0 - mx), e1 = __expf(a1 - mx), e2 = __expf(a2 - mx), e3 = __expf(a3 - mx), inv = 1.f / (e0 + e1 + e2 + e3);
        lbs[e] = 0.f; lbs[1024 + e] = e1 * inv; lbs[2048 + e] = (e1 + e2) * inv; lbs[3072 + e] = (e1 + e2 + e3) * inv; }
}

__device__ __forceinline__ void phase_norm(int layer, int G) {
    const KPtr p = kparams();
    const int tid = opaque_tid(), lane = tid & 63, wave = tid >> 6;
    const int gw = opaque_bid() * NWAVES + wave, NGW = G * NWAVES;
    const float* mod = (const float*)(p->ws + WS_MOD) + layer * 3072;
    const float* X = p->out + O_Y;
    bf16* HB = (bf16*)(p->ws + WS_HB);
    const f32x4* g4 = (const f32x4*)(p->norm_g + layer * D) + lane;
    for (int r = gw; r < M; r += NGW) {
        const float* xrow = (layer == 0) ? (r < MP ? p->x_prompt + (size_t)r * D : p->x_sample + (size_t)(r - MP) * D) : X + (size_t)r * D;
        const f32x4* xr = (const f32x4*)xrow + lane;
        f32x4 v[4]; float s = 0.f;
#pragma unroll
        for (int j = 0; j < 4; ++j) { v[j] = xr[64 * j]; s += (v[j].x * v[j].x + v[j].y * v[j].y) + (v[j].z * v[j].z + v[j].w * v[j].w); }
        const float rstd = 1.f / sqrtf(wave_sum(s) * (1.f / D) + EPS);
        const float* mr = mod + (size_t)mod_row(r) * MODLD;
        const f32x4* sh4 = (const f32x4*)mr + lane; const f32x4* sc4 = (const f32x4*)(mr + 1024) + lane;
        v2u* o8 = (v2u*)(HB + (size_t)r * D) + lane;
#pragma unroll
        for (int j = 0; j < 4; ++j) { const f32x4 g = g4[64 * j], sh = sh4[64 * j], sc = sc4[64 * j];
            const f32x4 h = v[j] * rstd * g * (sc + 1.f) + sh;
            v2u w; w.x = pk2(h.x, h.y); w.y = pk2(h.z, h.w); o8[64 * j] = w; }
    }
}

__device__ __forceinline__ void phase_final(int G) {
    const KPtr p = kparams();
    const int tid = opaque_tid(), lane = tid & 63, wave = tid >> 6;
    const int gw = opaque_bid() * NWAVES + wave, NGW = G * NWAVES;
    float* X = p->out + O_Y;
    const f32x4* g4 = (const f32x4*)p->final_norm_g + lane;
    for (int r = gw; r < M; r += NGW) {
        f32x4* xr = (f32x4*)(X + (size_t)r * D) + lane;
        f32x4 v[4]; float s = 0.f;
#pragma unroll
        for (int j = 0; j < 4; ++j) { v[j] = xr[64 * j]; s += (v[j].x * v[j].x + v[j].y * v[j].y) + (v[j].z * v[j].z + v[j].w * v[j].w); }
        const float rstd = 1.f / sqrtf(wave_sum(s) * (1.f / D) + EPS);
#pragma unroll
        for (int j = 0; j < 4; ++j) xr[64 * j] = v[j] * rstd * g4[64 * j];
    }
}

__device__ __forceinline__ void bf8_to_f(const v4u w, float (&f)[8]) {
#pragma unroll
    for (int i = 0; i < 4; ++i) { f[2 * i] = __builtin_bit_cast(float, w[i] << 16); f[2 * i + 1] = __builtin_bit_cast(float, w[i] & 0xffff0000u); }
}
__device__ __forceinline__ void phase_conv_y(int j, int G) {
    const KPtr p = kparams();
    const int tid = opaque_tid();
    const bf16* U = (const bf16*)(p->ws + WS_U); const bf16* GB = (const bf16*)(p->ws + WS_GB);
    bf16* YB = (bf16*)(p->ws + WS_HB);
    const int e = (tid & 127) * 8;
    float w0[8], w1[8], w2[8];
    { const float* cw = p->conv_w + (size_t)j * 3 * 1024 + e;
#pragma unroll
      for (int i = 0; i < 8; ++i) { w0[i] = cw[i]; w1[i] = cw[1024 + i]; w2[i] = cw[2048 + i]; } }
    const float* st = p->state_conv + (size_t)j * 128 * 2 * 1024;
    for (int rg = opaque_bid(); rg < M / 4; rg += G) {
        const int r = rg * 4 + (tid >> 7);
        const bool samp = r >= MP; const int t = samp ? ((r - MP) & 3) : (r & 2047); const int seq = samp ? ((r - MP) >> 2) : (r >> 11);
        float g[8], u0[8], u1[8], u2[8];
        bf8_to_f(*(const v4u*)(GB + (size_t)r * D + e), g);
        bf8_to_f(*(const v4u*)(U + (size_t)r * D + e), u0);
        if (t >= 1) bf8_to_f(*(const v4u*)(U + (size_t)(r - 1) * D + e), u1);
        else if (samp) {
#pragma unroll
            for (int i = 0; i < 8; ++i) u1[i] = st[((size_t)seq * 2 + 1) * 1024 + e + i]; }
        else {
#pragma unroll
            for (int i = 0; i < 8; ++i) u1[i] = 0.f; }
        if (t >= 2) bf8_to_f(*(const v4u*)(U + (size_t)(r - 2) * D + e), u2);
        else if (samp) {
#pragma unroll
            for (int i = 0; i < 8; ++i) u2[i] = st[((size_t)seq * 2 + t) * 1024 + e + i]; }
        else {
#pragma unroll
            for (int i = 0; i < 8; ++i) u2[i] = 0.f; }
        v4u o;
#pragma unroll
        for (int i = 0; i < 4; ++i) o[i] = pk2(g[2 * i] * (w0[2 * i] * u2[2 * i] + w1[2 * i] * u1[2 * i] + w2[2 * i] * u0[2 * i]),
                                               g[2 * i + 1] * (w0[2 * i + 1] * u2[2 * i + 1] + w1[2 * i + 1] * u1[2 * i + 1] + w2[2 * i + 1] * u0[2 * i + 1]));
        *(v4u*)(YB + (size_t)r * D + e) = o;
    }
}

__device__ __forceinline__ int pq(int e) { return 256 * (e >> 7) + (e & 127); }
__device__ __forceinline__ void phase_hgrn_prep(int layer, int G) {
    const KPtr p = kparams();
    const int tid = opaque_tid();
    const float* PROJ = (const float*)(p->ws + WS_PROJ);
    bf16* FRQ = (bf16*)(p->ws + WS_FRQ); bf16* FRK = (bf16*)(p->ws + WS_FRK); bf16* FRKT = (bf16*)(p->ws + WS_FRKT); bf16* FRV = (bf16*)(p->ws + WS_FRV);
    float* DEC = (float*)(p->ws + WS_DEC);
    const float* lbs = (const float*)(p->ws + WS_LBS) + layer * 1024;
    for (int it = opaque_bid(); it < 8 * 64 * 2; it += G) {
        const int bc = it >> 1, b = bc >> 6, c = bc & 63, e = (it & 1) * 512 + tid;
        const int h = e >> 7, k = e & 127, kt = k >> 5, kl = k & 31;
        const int ksk = kl >> 4, rem = kl & 15, hfk = (rem >> 2) & 1, jk = ((rem >> 3) << 2) | (rem & 3);
        const int vs = kt, vl = kl;
        const size_t base = ((size_t)((b * 8 + h) * 64 + c)) * 4096;
        const float lb = lbs[e];
        const int col = pq(e);
        float Gc = 0.f;
        for (int tg = 0; tg < 8; ++tg) {
            float kv[4], vv[4];
#pragma unroll
            for (int tt = 0; tt < 4; ++tt) {
                const int t = 4 * tg + tt;
                const float* pr = PROJ + (size_t)(b * 2048 + c * 32 + t) * NPROJ + col;
                const float q = pr[0], fp = pr[128], v = pr[2048];
                const float f = lb + (1.f - lb) * sigmoidf_(fp);
                Gc += __logf(f);
                const float qt = siluf_(q) * __expf(Gc), ktl = (1.f - f) * __expf(-Gc);
                const size_t o = base + ((size_t)((kt * 2 + ksk) * 64 + t + 32 * hfk)) * 8 + jk;
                FRQ[o] = f2bf(qt); FRK[o] = f2bf(ktl);
                kv[tt] = ktl; vv[tt] = v;
            }
            const int kss = tg >> 2, hfs = tg & 1, j0 = ((tg >> 1) & 1) * 4;
            v2u w; w.x = pk2(kv[0], kv[1]); w.y = pk2(kv[2], kv[3]);
            *(v2u*)(FRKT + base + ((size_t)((kt * 2 + kss) * 64 + kl + 32 * hfs)) * 8 + j0) = w;
            w.x = pk2(vv[0], vv[1]); w.y = pk2(vv[2], vv[3]);
            *(v2u*)(FRV + base + ((size_t)((vs * 2 + kss) * 64 + vl + 32 * hfs)) * 8 + j0) = w;
        }
        DEC[(size_t)(b * 64 + c) * 1024 + e] = __expf(Gc);
    }
}

#define MFMA32(a, b, c) __builtin_amdgcn_mfma_f32_32x32x16_bf16((a), (b), (c), 0, 0, 0)
__device__ __forceinline__ bf16x8 pack8(const f32x16& x, int s) {
    v4u w; w.x = pk2(x[8 * s + 0], x[8 * s + 1]); w.y = pk2(x[8 * s + 2], x[8 * s + 3]); w.z = pk2(x[8 * s + 4], x[8 * s + 5]); w.w = pk2(x[8 * s + 6], x[8 * s + 7]);
    return __builtin_bit_cast(bf16x8, w);
}
__device__ __forceinline__ void hgrn_prompt_item(int j, int item, int lane) {
    const KPtr p = kparams();
    const int b = item >> 5, h = (item >> 2) & 7, vs = item & 3, hf = lane >> 5, l31 = lane & 31;
    const bf16* FRQ = (const bf16*)(p->ws + WS_FRQ); const bf16* FRK = (const bf16*)(p->ws + WS_FRK); const bf16* FRKT = (const bf16*)(p->ws + WS_FRKT); const bf16* FRV = (const bf16*)(p->ws + WS_FRV);
    const float* DEC = (const float*)(p->ws + WS_DEC);
    float* O = (float*)(p->ws + WS_PROJ);
    f32x16 S[4];
#pragma unroll
    for (int kt = 0; kt < 4; ++kt)
#pragma unroll
        for (int i = 0; i < 16; ++i) S[kt][i] = 0.f;
    for (int c = 0; c < 64; ++c) {
        const size_t base = ((size_t)((b * 8 + h) * 64 + c)) * 4096;
        const bf16x8* qp = (const bf16x8*)(FRQ + base) + lane; const bf16x8* kp = (const bf16x8*)(FRK + base) + lane;
        const bf16x8* ktp = (const bf16x8*)(FRKT + base) + lane; const bf16x8* vp = (const bf16x8*)(FRV + base) + vs * 128 + lane;
        bf16x8 QF[8], KF[8], KT[8], VF[2];
#pragma unroll
        for (int f = 0; f < 8; ++f) { QF[f] = qp[f * 64]; KF[f] = kp[f * 64]; KT[f] = ktp[f * 64]; }
        VF[0] = vp[0]; VF[1] = vp[64];
        const float* dp = DEC + (size_t)(b * 64 + c) * 1024 + h * 128 + 4 * hf;
        f32x16 at;
#pragma unroll
        for (int i = 0; i < 16; ++i) at[i] = 0.f;
#pragma unroll
        for (int f = 0; f < 8; ++f) at = MFMA32(KF[f], QF[f], at);
#pragma unroll
        for (int i = 0; i < 16; ++i) { const int s = (i & 3) + 8 * (i >> 2) + 4 * hf; at[i] = (s <= l31) ? at[i] : 0.f; }
        const bf16x8 atp0 = pack8(at, 0), atp1 = pack8(at, 1);
        f32x16 o;
#pragma unroll
        for (int i = 0; i < 16; ++i) o[i] = 0.f;
#pragma unroll
        for (int kt = 0; kt < 4; ++kt) { o = MFMA32(pack8(S[kt], 0), QF[kt * 2], o); o = MFMA32(pack8(S[kt], 1), QF[kt * 2 + 1], o); }
        o = MFMA32(VF[0], atp0, o); o = MFMA32(VF[1], atp1, o);
        float* orow = O + (size_t)(b * 2048 + c * 32 + l31) * NPROJ + 256 * h + 32 * vs + 4 * hf;
#pragma unroll
        for (int g = 0; g < 4; ++g) *(f32x4*)(orow + 8 * g) = (f32x4){o[4 * g], o[4 * g + 1], o[4 * g + 2], o[4 * g + 3]};
#pragma unroll
        for (int kt = 0; kt < 4; ++kt) {
            S[kt] = MFMA32(KT[kt * 2], VF[0], S[kt]); S[kt] = MFMA32(KT[kt * 2 + 1], VF[1], S[kt]);
#pragma unroll
            for (int g = 0; g < 4; ++g) { const f32x4 d = *(const f32x4*)(dp + 32 * kt + 8 * g);
                S[kt][4 * g] *= d.x; S[kt][4 * g + 1] *= d.y; S[kt][4 * g + 2] *= d.z; S[kt][4 * g + 3] *= d.w; }
        }
    }
    float* so = p->out + O_HGP + ((size_t)((j * 8 + b) * 8 + h)) * 16384 + 32 * vs + l31;
#pragma unroll
    for (int kt = 0; kt < 4; ++kt)
#pragma unroll
        for (int i = 0; i < 16; ++i) so[(size_t)(32 * kt + (i & 3) + 8 * (i >> 2) + 4 * hf) * 128] = S[kt][i];
}

__device__ __forceinline__ void hgrn_sample_item(int layer, int j, int item, LAS float* L) {
    const KPtr p = kparams();
    const int tid = opaque_tid(), lane = tid & 63, wave = tid >> 6;
    const int s = item >> 3, h = item & 7;
    float* PROJ = (float*)(p->ws + WS_PROJ);
    const float* lbs = (const float*)(p->ws + WS_LBS) + layer * 1024;
    LAS float* qe = L;
    LAS float* kd = L + 512;
    LAS float* egl = L + 1024;
    LAS float* vv = L + 1152;
    LAS float* Ap = L + 1664;
    LAS float* part = L + 1728;
    const size_t r0 = (size_t)(MP + 4 * s);
    if (tid < 128) {
        const int k = tid; const float lb = lbs[h * 128 + k];
        float sq[4], kk[4], Gt[4]; float Gc = 0.f;
#pragma unroll
        for (int t = 0; t < 4; ++t) { const float* pr = PROJ + (r0 + t) * NPROJ + 256 * h + k;
            const float q = pr[0], fp = pr[128]; const float f = lb + (1.f - lb) * sigmoidf_(fp);
            Gc += __logf(f); Gt[t] = Gc; sq[t] = siluf_(q); kk[t] = 1.f - f; }
#pragma unroll
        for (int t = 0; t < 4; ++t) { qe[t * 128 + k] = sq[t] * __expf(Gt[t]); kd[t * 128 + k] = kk[t] * __expf(Gt[3] - Gt[t]); }
        egl[k] = __expf(Gt[3]);
#pragma unroll
        for (int t = 0; t < 4; ++t)
#pragma unroll
            for (int u = 0; u < 4; ++u) { float a = (u <= t) ? sq[t] * kk[u] * __expf(Gt[t] - Gt[u]) : 0.f; a = wave_sum(a); if (lane == 0) Ap[wave * 16 + t * 4 + u] = a; }
    } else if (tid < 256) {
        const int v = tid - 128;
#pragma unroll
        for (int t = 0; t < 4; ++t) vv[t * 128 + v] = PROJ[(r0 + t) * NPROJ + 2048 + 256 * h + v];
    }
    __syncthreads();
    {
        const int kg = tid >> 5, vg = tid & 31;
        const float* S0 = p->state_hgrn + ((size_t)((j * 128 + s) * 8 + h)) * 16384;
        float* S1 = p->out + O_HGS + ((size_t)((j * 128 + s) * 8 + h)) * 16384;
        f32x4 po[4];
#pragma unroll
        for (int t = 0; t < 4; ++t) po[t] = (f32x4){0.f, 0.f, 0.f, 0.f};
        f32x4 v4[4];
#pragma unroll
        for (int t = 0; t < 4; ++t) v4[t] = *(const LAS f32x4*)(vv + t * 128 + 4 * vg);
#pragma unroll
        for (int i = 0; i < 8; ++i) {
            const int k = 8 * kg + i;
            const f32x4 s0 = *(const f32x4*)(S0 + (size_t)k * 128 + 4 * vg);
            f32x4 sn = s0 * egl[k];
#pragma unroll
            for (int t = 0; t < 4; ++t) { sn += v4[t] * kd[t * 128 + k]; po[t] += s0 * qe[t * 128 + k]; }
            *(f32x4*)(S1 + (size_t)k * 128 + 4 * vg) = sn;
        }
#pragma unroll
        for (int t = 0; t < 4; ++t) *(LAS f32x4*)(part + (kg * 4 + t) * 128 + 4 * vg) = po[t];
    }
    __syncthreads();
    {
        const int t = tid >> 7, v = tid & 127;
        float o = 0.f;
#pragma unroll
        for (int kg = 0; kg < 16; ++kg) o += part[(kg * 4 + t) * 128 + v];
#pragma unroll
        for (int u = 0; u < 4; ++u) if (u <= t) o += (Ap[t * 4 + u] + Ap[16 + t * 4 + u]) * vv[u * 128 + v];
        PROJ[(r0 + t) * NPROJ + 256 * h + v] = o;
    }
    __syncthreads();
}

__device__ __forceinline__ void phase_hgrn_rec(int layer, int j, LAS unsigned char* lds, int G) {
    const KPtr p = kparams();
    const int tid = opaque_tid(), lane = tid & 63, wave = tid >> 6;
    for (int item = opaque_bid(); item < 1024; item += G) hgrn_sample_item(layer, j, item, (LAS float*)lds);
    if (wave == 0) for (int item = opaque_bid(); item < 256; item += G) hgrn_prompt_item(j, item, lane);
}

__device__ __forceinline__ void phase_hgrn_y(int j, int G) {
    const KPtr p = kparams();
    const int tid = opaque_tid(), lane = tid & 63, wave = tid >> 6;
    const int gw = opaque_bid() * NWAVES + wave, NGW = G * NWAVES;
    const float* PROJ = (const float*)(p->ws + WS_PROJ);
    bf16* YB = (bf16*)(p->ws + WS_HB);
    const float* og = p->hgrn_onorm_g + (size_t)j * 1024;
    for (int r = gw; r < M; r += NGW) {
        const float* pr = PROJ + (size_t)r * NPROJ;
#pragma unroll
        for (int jj = 0; jj < 4; ++jj) {
            const int e = 4 * lane + 256 * jj, h = e >> 7, v = e & 127;
            const f32x4 o = *(const f32x4*)(pr + 256 * h + v), z = *(const f32x4*)(pr + 2048 + 256 * h + 128 + v), g = *(const f32x4*)(og + e);
            float ss = (o.x * o.x + o.y * o.y) + (o.z * o.z + o.w * o.w);
#pragma unroll
            for (int m = 1; m < 32; m <<= 1) ss += __shfl_xor(ss, m);
            const float rs = 1.f / sqrtf(ss * (1.f / 128.f) + EPS);
            v2u w; w.x = pk2(o.x * rs * g.x * siluf_(z.x), o.y * rs * g.y * siluf_(z.y)); w.y = pk2(o.z * rs * g.z * siluf_(z.z), o.w * rs * g.w * siluf_(z.w));
            *(v2u*)(YB + (size_t)r * D + e) = w;
        }
    }
}

__device__ __forceinline__ void phase_ada_gemm(LAS unsigned char* lds, int G) {
    const KPtr p = kparams(); unsigned char* ws = p->ws;
    pg8::Gemm g{(const pg8::bf16_t*)(ws + WS_ACT), (const pg8::bf16_t*)(ws + WS_WADA), 256, MODLD, 1024}; pg8::StaticOrder S; S.init(256, MODLD, G, opaque_bid());
    EpiStoreF32 E{(float*)(ws + WS_MOD), MODLD, p->b_ada};
    pg8::gemm_phase<EpiStoreF32, pg8::StaticOrder, true, true>(lds, g, S, E);
}
__device__ __forceinline__ void phase_in_gemm_conv(int j, LAS unsigned char* lds, int G) {
    const KPtr p = kparams(); unsigned char* ws = p->ws;
    const bf16* W = (const bf16*)(ws + WS_WCIN) + (size_t)j * 4096 * 1024;
    pg8::Gemm g{(const pg8::bf16_t*)(ws + WS_HB), W, M, NPROJ, 1024}; pg8::StaticOrder S; S.init(M, NPROJ, G, opaque_bid());
    EpiConv E{(bf16*)(ws + WS_U), (bf16*)(ws + WS_GB), p->out + O_CONVP + (size_t)j * 8 * 2 * 1024, p->out + O_CONVS + (size_t)j * 128 * 2 * 1024};
    pg8::gemm_phase<EpiConv, pg8::StaticOrder, true, true>(lds, g, S, E);
}
__device__ __forceinline__ void phase_in_gemm_hgrn(int j, LAS unsigned char* lds, int G) {
    const KPtr p = kparams(); unsigned char* ws = p->ws;
    const bf16* W = (const bf16*)(ws + WS_WHIN) + (size_t)j * 4096 * 1024;
    pg8::Gemm g{(const pg8::bf16_t*)(ws + WS_HB), W, M, NPROJ, 1024}; pg8::StaticOrder S; S.init(M, NPROJ, G, opaque_bid());
    EpiStoreF32 E{(float*)(ws + WS_PROJ), NPROJ, nullptr};
    pg8::gemm_phase<EpiStoreF32, pg8::StaticOrder, true, true>(lds, g, S, E);
}
__device__ __forceinline__ void phase_out_gemm(int layer, LAS unsigned char* lds, int G) {
    const KPtr p = kparams(); unsigned char* ws = p->ws;
    const int j = layer >> 1;
    float* X = p->out + O_Y;
    const bf16* W = (const bf16*)(ws + ((layer & 1) ? WS_WHOUT : WS_WCOUT)) + (size_t)j * 1024 * 1024;
    pg8::Gemm g{(const pg8::bf16_t*)(ws + WS_HB), W, M, D, 1024}; pg8::StaticOrder S; S.init(M, D, G, opaque_bid());
    EpiResid E{layer == 0 ? p->x_prompt : X, layer == 0 ? p->x_sample : X + (size_t)MP * D, X, (const float*)(ws + WS_MOD) + layer * 3072 + 2048};
    pg8::gemm_phase<EpiResid, pg8::StaticOrder, true, true>(lds, g, S, E);
}

__global__ void __launch_bounds__(NTHREADS, 2) fwd_megakernel(Params p_unused) {
    extern __shared__ __attribute__((aligned(16))) unsigned char lds_raw[];
    LAS unsigned char* lds = (LAS unsigned char*)lds_raw;
    cg::grid_group grid = cg::this_grid();
    const int G = gridDim.x;

    phase_prologue(lds, G);
    grid.sync();
    phase_ada_gemm(lds, G);
    grid.sync();
#pragma unroll 1
    for (int layer = 0; layer < 4; ++layer) {
        const int j = layer >> 1; const bool is_conv = (layer & 1) == 0;
        phase_norm(layer, G);
        grid.sync();
        if (is_conv) { phase_in_gemm_conv(j, lds, G); grid.sync(); phase_conv_y(j, G); }
        else {
            phase_in_gemm_hgrn(j, lds, G);
            grid.sync();
            phase_hgrn_prep(layer, G);
            grid.sync();
            phase_hgrn_rec(layer, j, lds, G);
            grid.sync();
            phase_hgrn_y(j, G);
        }
        grid.sync();
        phase_out_gemm(layer, lds, G);
        grid.sync();
    }
    phase_final(G);
}

extern "C" void kernel_launch(void* const* d_in, const int* in_sizes, int n_in, void* d_out, int out_size, void* d_ws, size_t ws_size, hipStream_t stream) {
    static int grid_blocks = 0;
    if (grid_blocks == 0) {
        if (n_in != 17 || ws_size < WS_END) { fprintf(stderr, "kernel_launch: unexpected n_in %d or ws_size %zu (< %zu)\n", n_in, ws_size, (size_t)WS_END); grid_blocks = -1; return; }
        int dev = 0, cus = 0, per_cu = 0;
        hipGetDevice(&dev);
        hipDeviceGetAttribute(&cus, hipDeviceAttributeMultiprocessorCount, dev);
        if (hipFuncSetAttribute((const void*)fwd_megakernel, hipFuncAttributeMaxDynamicSharedMemorySize, LDS_BYTES) != hipSuccess) { fprintf(stderr, "kernel_launch: hipFuncSetAttribute failed\n"); grid_blocks = -1; return; }
        hipOccupancyMaxActiveBlocksPerMultiprocessor(&per_cu, (const void*)fwd_megakernel, NTHREADS, LDS_BYTES);
        if (per_cu < 1) { fprintf(stderr, "kernel_launch: occupancy query returned %d\n", per_cu); per_cu = 1; }
        grid_blocks = cus * per_cu;
    }
    if (grid_blocks < 0) return;
    Params p{};
    p.x_prompt = (const float*)d_in[0]; p.x_sample = (const float*)d_in[1]; p.state_conv = (const float*)d_in[2]; p.state_hgrn = (const float*)d_in[3];
    p.c_prompt = (const float*)d_in[4]; p.c_sample = (const float*)d_in[5]; p.norm_g = (const float*)d_in[6]; p.w_ada = (const float*)d_in[7]; p.b_ada = (const float*)d_in[8];
    p.conv_w_in = (const float*)d_in[9]; p.conv_w = (const float*)d_in[10]; p.conv_w_out = (const float*)d_in[11]; p.hgrn_w_in = (const float*)d_in[12];
    p.hgrn_lb = (const float*)d_in[13]; p.hgrn_onorm_g = (const float*)d_in[14]; p.hgrn_w_out = (const float*)d_in[15]; p.final_norm_g = (const float*)d_in[16];
    p.out = (float*)d_out; p.ws = (unsigned char*)d_ws;
    void* args[] = {&p};
    hipError_t e = hipLaunchCooperativeKernel((const void*)fwd_megakernel, dim3(grid_blocks), dim3(NTHREADS), args, LDS_BYTES, stream);
    if (e != hipSuccess) fprintf(stderr, "cooperative launch failed: %s (grid %d)\n", hipGetErrorString(e), grid_blocks);
}
```

```cpp
#include <hip/hip_runtime.h>
#include <hip/hip_cooperative_groups.h>
#include <cstdio>
#include <cstdint>
namespace cg = cooperative_groups;
__device__ __forceinline__ int opaque_tid() { int t = (int)threadIdx.x; asm volatile("" : "+v"(t)); return t; }
__device__ __forceinline__ int opaque_bid() { int b = (int)blockIdx.x; asm volatile("" : "+s"(b)); return b; }
__device__ __forceinline__ int opaque_s(int x) { asm volatile("" : "+s"(x)); return x; }
namespace pg8 {
#define PG8_LAS __attribute__((address_space(3)))
typedef unsigned short bf16_t;
typedef short bf16x8 __attribute__((ext_vector_type(8)));
typedef float f32x4 __attribute__((ext_vector_type(4)));
typedef unsigned u32x4 __attribute__((ext_vector_type(4)));
constexpr int BM = 256, BK = 64, HALF = 128, HTB = HALF * BK * 2  , STAGE_BYTES = 8 * HTB, NXCD = 8, WGM = 8;

__host__ __device__ __forceinline__ int lds_byte(int r, int c) { const int st = (r >> 4) * 2 + (c >> 5), rr = r & 15, cc = c & 31, ob = rr * 64 + cc * 2; return st * 1024 + (ob ^ (((ob >> 9) & 1) << 5)); }
__host__ __device__ __forceinline__ void stage_rc(int b, int& R, int& C) { const int st = b / 1024, sb = b % 1024, swz = sb ^ (((sb >> 9) & 1) << 5); R = (st >> 1) * 16 + swz / 64; C = (st & 1) * 32 + (swz % 64) / 2; }
__host__ __device__ __forceinline__ int perm32(int rho) { const int n = rho >> 4, i = rho & 15; return 8 * (i >> 2) + 4 * n + (i & 3); }

struct Unit { int pm, pn; };
struct Gemm { const bf16_t* A; const bf16_t* Bt; int M, N, K; };

struct StaticOrder {
    int nM, nN, nwg, G, c;
    __host__ __device__ void init(int M, int N, int G_, int c_) { nM = M / BM; nN = N / BM; nwg = nM * nN; G = G_; c = c_; }
    __host__ __device__ bool next(int i, Unit& u) const {
        const long L = (long)i * G + c; if (L >= nwg) return false;
        int wgid = (int)L; { const int q = nwg / NXCD, r = nwg % NXCD, xcd = wgid % NXCD, off = wgid / NXCD; wgid = (xcd < r ? xcd * (q + 1) : r * (q + 1) + (xcd - r) * q) + off; }
        const int nig = WGM * nN, gid = wgid / nig, fm = gid * WGM, gsz = (nM - fm) < WGM ? (nM - fm) : WGM;
        u.pm = fm + ((wgid % nig) % gsz); u.pn = (wgid % nig) / gsz; return true;
    }
    __device__ __forceinline__ void a_ready(const Unit&) const {}
    __device__ __forceinline__ void done(const Unit&) const {}
};

__device__ __forceinline__ unsigned cvt_pk_bf16(float lo, float hi) { unsigned r; asm volatile("v_cvt_pk_bf16_f32 %0, %1, %2" : "=v"(r) : "v"(lo), "v"(hi)); return r; }
template <class Epi, class Sched, bool ALIGN_EPI = false, bool SP2 = false>
__device__ __forceinline__ void gemm_phase(PG8_LAS unsigned char* lds, const Gemm g, const Sched& S, const Epi& E) {
    const int tid = opaque_tid(), wid = __builtin_amdgcn_readfirstlane(tid >> 6), lane = tid & 63, wr = wid >> 2, wc = wid & 3, fr = lane & 15, fq = lane >> 4;
    const int K = g.K, nt = K / BK;
    unsigned voffA[2], voffB[2];
#pragma unroll
    for (int i = 0; i < 2; ++i) { int R, C; stage_rc(tid * 16 + i * 8192, R, C); const int Rb = Epi::PERM ? ((R & ~31) + perm32(R & 31)) : R;
        voffA[i] = (unsigned)(R * K + C) * 2u; voffB[i] = (unsigned)(Rb * K + C) * 2u; }
    const size_t kstep = (size_t)(BK * 2);
    const size_t hstep = (size_t)HALF * K * 2;
    const size_t tstep = 2 * hstep;
    const unsigned ldsw = (unsigned)wid * 1024u;
    const int aoff = lds_byte(wr * 64 + fr, fq * 8), boff = lds_byte(wc * 32 + fr, fq * 8);
#define PG8_SA(b, h) (((b) * 2 + (h)) * HTB)
#define PG8_SB(b, h) ((4 + (b) * 2 + (h)) * HTB)
#define PG8_STAGE(bufoff, gbase, voff) do { _Pragma("unroll") for (int _i = 0; _i < 2; ++_i) \
        __builtin_amdgcn_global_load_lds((const unsigned*)((const char*)(gbase) + (voff)[_i]), (PG8_LAS unsigned*)(lds + (bufoff) + ldsw + _i * 8192), 16, 0, 0); } while (0)
#define PG8_LDA(dst, b, h) do { _Pragma("unroll") for (int m = 0; m < 4; ++m) _Pragma("unroll") for (int k = 0; k < 2; ++k) dst[m][k] = *(const PG8_LAS bf16x8*)(lds + PG8_SA(b, h) + aoff + m * 2048 + k * 1024); } while (0)
#define PG8_LDB(dst, b, h) do { _Pragma("unroll") for (int n = 0; n < 2; ++n) _Pragma("unroll") for (int k = 0; k < 2; ++k) dst[n][k] = *(const PG8_LAS bf16x8*)(lds + PG8_SB(b, h) + boff + n * 2048 + k * 1024); } while (0)
#define PG8_MMA(ai, bj, At, Bt) do { __builtin_amdgcn_s_setprio(1); _Pragma("unroll") for (int m = 0; m < 4; ++m) _Pragma("unroll") for (int n = 0; n < 2; ++n) _Pragma("unroll") for (int k = 0; k < 2; ++k) \
        acc[ai][bj][m][n] = __builtin_amdgcn_mfma_f32_16x16x32_bf16(Bt[n][k], At[m][k], acc[ai][bj][m][n], 0, 0, 0); __builtin_amdgcn_s_setprio(0); } while (0)
#define PG8_WAIT_V(n) asm volatile("s_waitcnt vmcnt(" #n ")" ::: "memory")
#define PG8_WAIT_L(n) asm volatile("s_waitcnt lgkmcnt(" #n ")" ::: "memory")
#define PG8_BAR __builtin_amdgcn_s_barrier()
#define PG8_SCHED __builtin_amdgcn_sched_barrier(0)
    Unit cur, nxt; int ui = 0;
    if (!S.next(0, cur)) return;
    f32x4 acc[2][2][4][2];
#pragma unroll
    for (int a = 0; a < 2; ++a)
#pragma unroll
        for (int b = 0; b < 2; ++b)
#pragma unroll
            for (int m = 0; m < 4; ++m)
#pragma unroll
                for (int n = 0; n < 2; ++n) acc[a][b][m][n] = (f32x4){0.f, 0.f, 0.f, 0.f};
    bf16x8 At[4][2], B0[2][2], B1[2][2];
    const char* cA = (const char*)g.A + (size_t)cur.pm * tstep; const char* cB = (const char*)g.Bt + (size_t)cur.pn * tstep;
    S.a_ready(cur);
    if constexpr (SP2) {
        PG8_STAGE(PG8_SB(0, 0), cB, voffB); PG8_STAGE(PG8_SB(0, 1), cB + hstep, voffB); PG8_STAGE(PG8_SA(0, 0), cA, voffA); PG8_STAGE(PG8_SA(0, 1), cA + hstep, voffA);
        if (wr == 1) PG8_BAR;
        PG8_WAIT_V(2); PG8_BAR;
        PG8_STAGE(PG8_SB(1, 0), cB + kstep, voffB); PG8_STAGE(PG8_SA(1, 0), cA + kstep, voffA); PG8_STAGE(PG8_SB(1, 1), cB + hstep + kstep, voffB);
        PG8_WAIT_V(6); PG8_BAR;
    } else {
        PG8_STAGE(PG8_SB(0, 0), cB, voffB); PG8_STAGE(PG8_SA(0, 0), cA, voffA); PG8_STAGE(PG8_SB(0, 1), cB + hstep, voffB); PG8_STAGE(PG8_SA(0, 1), cA + hstep, voffA);
        if (wr == 1) PG8_BAR;
        PG8_WAIT_V(4); PG8_BAR;
        PG8_STAGE(PG8_SB(1, 0), cB + kstep, voffB); PG8_STAGE(PG8_SA(1, 0), cA + kstep, voffA); PG8_STAGE(PG8_SB(1, 1), cB + hstep + kstep, voffB);
        PG8_WAIT_V(6); PG8_BAR;
    }
    for (;;) {
        const bool has_next = S.next(ui + 1, nxt);
        const char* nA = has_next ? (const char*)g.A + (size_t)nxt.pm * tstep : cA; const char* nB = has_next ? (const char*)g.Bt + (size_t)nxt.pn * tstep : cB;
        for (int t = 0; t < nt; t += 2) {
            const bool last = (t == nt - 2);
            const char* a1 = cA + (size_t)(t + 1) * kstep;
            const char* a2 = last ? nA : cA + (size_t)(t + 2) * kstep; const char* b2 = last ? nB : cB + (size_t)(t + 2) * kstep;
            const char* a3 = a2 + kstep; const char* b3 = b2 + kstep;
            if (last && has_next) S.a_ready(nxt);
            if constexpr (SP2) {
            PG8_LDB(B0, 0, 0); PG8_LDB(B1, 0, 1); PG8_SCHED; PG8_LDA(At, 0, 0); PG8_STAGE(PG8_SA(1, 1), a1 + hstep, voffA);
            PG8_WAIT_V(8); PG8_WAIT_L(0); PG8_BAR; PG8_MMA(0, 0, At, B0); PG8_MMA(0, 1, At, B1); PG8_BAR; PG8_SCHED;
            PG8_LDA(At, 0, 1); PG8_STAGE(PG8_SB(0, 0), b2, voffB); PG8_STAGE(PG8_SB(0, 1), b2 + hstep, voffB); PG8_STAGE(PG8_SA(0, 0), a2, voffA);
            PG8_WAIT_V(8); PG8_WAIT_L(0); PG8_BAR; PG8_MMA(1, 0, At, B0); PG8_MMA(1, 1, At, B1); PG8_BAR; PG8_SCHED;
            PG8_LDB(B0, 1, 0); PG8_LDB(B1, 1, 1); PG8_SCHED; PG8_LDA(At, 1, 0); PG8_STAGE(PG8_SA(0, 1), a2 + hstep, voffA);
            PG8_WAIT_V(8); PG8_WAIT_L(0); PG8_BAR; PG8_MMA(0, 0, At, B0); PG8_MMA(0, 1, At, B1); PG8_BAR; PG8_SCHED;
            PG8_LDA(At, 1, 1); PG8_STAGE(PG8_SB(1, 0), b3, voffB); PG8_STAGE(PG8_SB(1, 1), b3 + hstep, voffB); PG8_STAGE(PG8_SA(1, 0), a3, voffA);
            PG8_WAIT_V(8); PG8_WAIT_L(0); PG8_BAR; PG8_MMA(1, 0, At, B0); PG8_MMA(1, 1, At, B1); PG8_BAR; PG8_SCHED;
            } else {
            PG8_LDB(B0, 0, 0); PG8_SCHED; PG8_LDA(At, 0, 0); PG8_STAGE(PG8_SA(1, 1), a1 + hstep, voffA);
            PG8_WAIT_L(8); PG8_BAR; PG8_WAIT_L(0); PG8_MMA(0, 0, At, B0); PG8_BAR; PG8_SCHED;
            PG8_LDB(B1, 0, 1); PG8_STAGE(PG8_SB(0, 0), b2, voffB);
            PG8_BAR; PG8_WAIT_L(0); PG8_MMA(0, 1, At, B1); PG8_BAR;
            PG8_LDA(At, 0, 1); PG8_STAGE(PG8_SA(0, 0), a2, voffA);
            PG8_BAR; PG8_WAIT_L(0); PG8_MMA(1, 0, At, B0); PG8_BAR; PG8_SCHED;
            PG8_STAGE(PG8_SB(0, 1), b2 + hstep, voffB);
            PG8_WAIT_V(6); PG8_BAR; PG8_MMA(1, 1, At, B1); PG8_BAR;
            PG8_LDB(B0, 1, 0); PG8_SCHED; PG8_LDA(At, 1, 0); PG8_STAGE(PG8_SA(0, 1), a2 + hstep, voffA);
            PG8_WAIT_L(8); PG8_BAR; PG8_WAIT_L(0); PG8_MMA(0, 0, At, B0); PG8_BAR; PG8_SCHED;
            PG8_LDB(B1, 1, 1); PG8_STAGE(PG8_SB(1, 0), b3, voffB);
            PG8_BAR; PG8_WAIT_L(0); PG8_MMA(0, 1, At, B1); PG8_BAR;
            PG8_LDA(At, 1, 1); PG8_STAGE(PG8_SA(1, 0), a3, voffA);
            PG8_BAR; PG8_WAIT_L(0); PG8_MMA(1, 0, At, B0); PG8_BAR; PG8_SCHED;
            PG8_STAGE(PG8_SB(1, 1), b3 + hstep, voffB);
            PG8_WAIT_V(6); PG8_BAR; PG8_MMA(1, 1, At, B1); PG8_BAR;
            }
        }
        if constexpr (ALIGN_EPI) { if (wr == 0) PG8_BAR; }
        if constexpr (!Epi::AFTER_DRAIN) { E(acc, cur, wr, wc, fr, fq); S.done(cur); }
        if (!has_next) break;
#pragma unroll
        for (int a = 0; a < 2; ++a)
#pragma unroll
            for (int b = 0; b < 2; ++b)
#pragma unroll
                for (int m = 0; m < 4; ++m)
#pragma unroll
                    for (int n = 0; n < 2; ++n) acc[a][b][m][n] = (f32x4){0.f, 0.f, 0.f, 0.f};
        cur = nxt; cA = nA; cB = nB; ++ui;
        if constexpr (ALIGN_EPI) { if (wr == 1) PG8_BAR; }
    }
    PG8_WAIT_V(0);
    if constexpr (!ALIGN_EPI) { if (wr == 0) PG8_BAR; }
    PG8_BAR;
    if constexpr (Epi::AFTER_DRAIN) { E.fused(acc, cur, wr, wc, fr, fq, lds, wid, lane); S.done(cur); }
#undef PG8_SA
#undef PG8_SB
#undef PG8_STAGE
#undef PG8_LDA
#undef PG8_LDB
#undef PG8_MMA
#undef PG8_WAIT_V
#undef PG8_WAIT_L
#undef PG8_BAR
#undef PG8_SCHED
}
}

constexpr int NWAVES = 8, NTHREADS = 512;
constexpr int D = 1024, MP = 16384, MS = 512, M = MP + MS, NPROJ = 4096;
constexpr int MODLD = 12288;
constexpr float EPS = 1e-6f;
constexpr size_t O_Y = 0, O_CONVP = 17301504, O_HGP = 17334272, O_CONVS = 19431424, O_HGS = 19955712;
constexpr size_t MiB = 1u << 20;
constexpr size_t WS_WCIN = 1 * MiB, WS_WHIN = 17 * MiB, WS_WCOUT = 33 * MiB, WS_WHOUT = 37 * MiB, WS_MOD = 41 * MiB, WS_ACT = 53 * MiB,
                 WS_LBS = 54 * MiB, WS_DEC = 55 * MiB, WS_HB = 57 * MiB, WS_FRQ = 90 * MiB, WS_FRK = 122 * MiB, WS_FRKT = 154 * MiB, WS_FRV = 186 * MiB,
                 WS_PROJ = 218 * MiB, WS_WADA = WS_PROJ, WS_U = WS_PROJ, WS_GB = WS_PROJ + 33 * MiB, WS_OB = WS_PROJ + 66 * MiB, WS_SZ = WS_PROJ + 132 * MiB, WS_SPROJ = WS_PROJ + 165 * MiB, WS_END = 482 * MiB;
constexpr int LDS_BYTES = 147456;

#define LAS __attribute__((address_space(3)))
typedef unsigned short bf16;
typedef unsigned v4u __attribute__((ext_vector_type(4)));
typedef unsigned v2u __attribute__((ext_vector_type(2)));
typedef float f32x4 __attribute__((ext_vector_type(4)));
typedef float f32x2 __attribute__((ext_vector_type(2)));
typedef float f32x16 __attribute__((ext_vector_type(16)));
typedef short bf16x8 __attribute__((ext_vector_type(8)));
typedef __bf16 bf16x2n __attribute__((ext_vector_type(2)));
#define LDS_WAIT() asm volatile("s_waitcnt lgkmcnt(0)" ::: "memory")

__device__ __forceinline__ unsigned pk2(float lo, float hi) { f32x2 v = {lo, hi}; return __builtin_bit_cast(unsigned, __builtin_convertvector(v, bf16x2n)); }
__device__ __forceinline__ unsigned short f2bf(float f) { return (unsigned short)(pk2(f, 0.f) & 0xffffu); }
__device__ __forceinline__ float sigmoidf_(float x) { return 1.f / (1.f + __expf(-x)); }
__device__ __forceinline__ float siluf_(float x) { return x * sigmoidf_(x); }
__device__ __forceinline__ float wave_sum(float v) {
#pragma unroll
    for (int o = 1; o < 64; o <<= 1) v += __shfl_xor(v, o);
    return v;
}
__device__ __forceinline__ int mod_row(int r) { return r < MP ? (r >> 11) : 8 + ((r - MP) >> 2); }

struct Params {
    const float* x_prompt; const float* x_sample; const float* state_conv; const float* state_hgrn;
    const float* c_prompt; const float* c_sample; const float* norm_g; const float* w_ada; const float* b_ada;
    const float* conv_w_in; const float* conv_w; const float* conv_w_out; const float* hgrn_w_in;
    const float* hgrn_lb; const float* hgrn_onorm_g; const float* hgrn_w_out; const float* final_norm_g;
    float* out; unsigned char* ws;
};


typedef const Params __attribute__((address_space(4))) * KPtr;
__device__ __forceinline__ KPtr kparams() { KPtr q = (KPtr)__builtin_amdgcn_kernarg_segment_ptr(); asm volatile("" : "+s"(q)); return q; }
#define KP(field) (kparams()->field)

struct EpiStoreF32 {
    static constexpr bool PERM = false, AFTER_DRAIN = false;
    float* C; int ldc; const float* bias;
    __device__ __forceinline__ void operator()(const f32x4 (&acc)[2][2][4][2], const pg8::Unit& u, int wr, int wc, int fr, int fq) const {
        const int row0 = u.pm * 256 + wr * 64 + fr, col0 = u.pn * 256 + wc * 32 + 4 * fq;
        f32x4 bv[2][2];
#pragma unroll
        for (int bj = 0; bj < 2; ++bj)
#pragma unroll
            for (int n = 0; n < 2; ++n) bv[bj][n] = bias ? *(const f32x4*)(bias + col0 + bj * 128 + n * 16) : (f32x4){0.f, 0.f, 0.f, 0.f};
#pragma unroll
        for (int ai = 0; ai < 2; ++ai)
#pragma unroll
            for (int m = 0; m < 4; ++m) { float* rowp = C + (size_t)(row0 + ai * 128 + m * 16) * ldc + col0;
#pragma unroll
                for (int bj = 0; bj < 2; ++bj)
#pragma unroll
                    for (int n = 0; n < 2; ++n) *(f32x4*)(rowp + bj * 128 + n * 16) = acc[ai][bj][m][n] + bv[bj][n]; }
    }
};
struct EpiResid {
    static constexpr bool PERM = false, AFTER_DRAIN = false;
    const float* xp; const float* xs;
    float* X; const float* gate;
    __device__ __forceinline__ void operator()(const f32x4 (&acc)[2][2][4][2], const pg8::Unit& u, int wr, int wc, int fr, int fq) const {
        const int row0 = u.pm * 256 + wr * 64 + fr, col0 = u.pn * 256 + wc * 32 + 4 * fq;
#pragma unroll
        for (int ai = 0; ai < 2; ++ai)
#pragma unroll
            for (int m = 0; m < 4; ++m) {
                const int r = row0 + ai * 128 + m * 16;
                const float* xo = (r < MP) ? xp + (size_t)r * D : xs + (size_t)(r - MP) * D;
                const float* gp = gate + (size_t)mod_row(r) * MODLD;
                float* xn = X + (size_t)r * D;
#pragma unroll
                for (int bj = 0; bj < 2; ++bj)
#pragma unroll
                    for (int n = 0; n < 2; ++n) { const int c = col0 + bj * 128 + n * 16;
                        const f32x4 xv = *(const f32x4*)(xo + c), gv = *(const f32x4*)(gp + c);
                        *(f32x4*)(xn + c) = xv + gv * acc[ai][bj][m][n]; } }
    }
};


__device__ __forceinline__ f32x4 silu4(f32x4 z) { return (f32x4){siluf_(z.x), siluf_(z.y), siluf_(z.z), siluf_(z.w)}; }
struct EpiConv {
    static constexpr bool PERM = false, AFTER_DRAIN = false;
    bf16* U; bf16* GB; float* convp; float* convs;
    __device__ __forceinline__ void operator()(const f32x4 (&acc)[2][2][4][2], const pg8::Unit& u, int wr, int wc, int fr, int fq) const {
        const int row0 = u.pm * 256 + wr * 64 + fr, e0 = u.pn * 64 + wc * 16 + 4 * fq;
#pragma unroll
        for (int ai = 0; ai < 2; ++ai)
#pragma unroll
            for (int m = 0; m < 4; ++m) {
                const int r = row0 + ai * 128 + m * 16;
                const f32x4 u4 = acc[ai][0][m][1] * acc[ai][1][m][0];
                const f32x4 g4 = acc[ai][0][m][0] * silu4(acc[ai][1][m][1]);
                v2u w; w.x = pk2(u4.x, u4.y); w.y = pk2(u4.z, u4.w); *(v2u*)(U + (size_t)r * D + e0) = w;
                w.x = pk2(g4.x, g4.y); w.y = pk2(g4.z, g4.w); *(v2u*)(GB + (size_t)r * D + e0) = w;
                if (r < MP) { const int t = r & 2047; if (t >= 2046) *(f32x4*)(convp + ((size_t)(r >> 11) * 2 + (t - 2046)) * 1024 + e0) = u4; }
                else { const int t = (r - MP) & 3; if (t >= 2) *(f32x4*)(convs + ((size_t)((r - MP) >> 2) * 2 + (t - 2)) * 1024 + e0) = u4; }
            }
    }
};


template <int CTRL> __device__ __forceinline__ float dppf(float x) { return __builtin_bit_cast(float, __builtin_amdgcn_update_dpp(0, __builtin_bit_cast(int, x), CTRL, 0xf, 0xf, false)); }
__device__ __forceinline__ float scan16(float x) {
    x += dppf<0x111>(x); x += dppf<0x112>(x); x += dppf<0x114>(x); x += dppf<0x118>(x); return x;
}
__device__ __forceinline__ void quad_transpose(float (&x)[4], int lane) {
    const bool p0 = (lane & 1) != 0, p1 = (lane & 2) != 0;
#pragma unroll
    for (int c = 0; c < 4; c += 2) { const float send = p0 ? x[c] : x[c + 1]; const float recv = dppf<0xB1>(send); if (p0) x[c] = recv; else x[c + 1] = recv; }
#pragma unroll
    for (int c = 0; c < 2; ++c) { const float send = p1 ? x[c] : x[c + 2]; const float recv = dppf<0x4E>(send); if (p1) x[c] = recv; else x[c + 2] = recv; }
}
__device__ __forceinline__ float ex2(float x) { return __builtin_amdgcn_exp2f(x); }
__device__ __forceinline__ float sigm2(float x) { return __builtin_amdgcn_rcpf(1.f + ex2(-1.4426950408889634f * x)); }

struct EpiHgrn {
    static constexpr bool PERM = false, AFTER_DRAIN = false;
    bf16 *FRQ, *FRK, *FRKT, *FRV, *SZ; float *DEC, *SPROJ; const float* lbs;
    __device__ __forceinline__ void operator()(const f32x4 (&acc)[2][2][4][2], const pg8::Unit& u, int wr, int wc, int fr, int fq) const {
        const int h = u.pn & 7; const bool qf = u.pn < 8;
        const int lr0 = wr * 64 + fr, lane = fr + 16 * fq;
        const int cin = 32 * wc + 4 * fq;
        if (u.pm >= 64) {
            const int row0 = (u.pm - 64) * 256 + lr0;
#pragma unroll
            for (int ai = 0; ai < 2; ++ai)
#pragma unroll
                for (int m = 0; m < 4; ++m) { const int row = row0 + ai * 128 + m * 16; float* rp = SPROJ + (size_t)row * NPROJ + u.pn * 256 + cin;
#pragma unroll
                    for (int n = 0; n < 2; ++n) {
                        *(f32x4*)(rp + 16 * n) = acc[ai][0][m][n];
                        if (qf) *(f32x4*)(rp + 128 + 16 * n) = acc[ai][1][m][n];
                        else { const f32x4 z = acc[ai][1][m][n]; v2u w; w.x = pk2(siluf_(z.x), siluf_(z.y)); w.y = pk2(siluf_(z.z), siluf_(z.w));
                            *(v2u*)(SZ + (size_t)(MP + row) * D + h * 128 + cin + 16 * n) = w; } } }
            return;
        }
        const int b = u.pm >> 3, cbase = (u.pm & 7) * 8;
        const int hfs = (fr >> 2) & 1, j0s = 4 * (fr >> 3);
        if (!qf) {
#pragma unroll
            for (int ai = 0; ai < 2; ++ai)
#pragma unroll
                for (int m = 0; m < 4; ++m) {
                    const int r = u.pm * 256 + lr0 + ai * 128 + m * 16, c = cbase + 4 * ai + 2 * wr + (m >> 1);
                    const size_t base = ((size_t)((b * 8 + h) * 64 + c)) * 4096;
#pragma unroll
                    for (int n = 0; n < 2; ++n) {
                        const f32x4 z = acc[ai][1][m][n]; v2u w; w.x = pk2(siluf_(z.x), siluf_(z.y)); w.y = pk2(siluf_(z.z), siluf_(z.w));
                        *(v2u*)(SZ + (size_t)r * D + h * 128 + cin + 16 * n) = w;
                        float x[4] = {acc[ai][0][m][n].x, acc[ai][0][m][n].y, acc[ai][0][m][n].z, acc[ai][0][m][n].w};
                        quad_transpose(x, lane);
                        w.x = pk2(x[0], x[1]); w.y = pk2(x[2], x[3]);
                        *(v2u*)(FRV + base + ((size_t)((wc * 2 + (m & 1)) * 64 + 16 * n + 4 * fq + (fr & 3) + 32 * hfs)) * 8 + j0s) = w;
                    }
                }
            return;
        }
        f32x4 lb4[2];
#pragma unroll
        for (int n = 0; n < 2; ++n) lb4[n] = *(const f32x4*)(lbs + h * 128 + cin + 16 * n);
#pragma unroll
        for (int ai = 0; ai < 2; ++ai)
#pragma unroll
            for (int mp = 0; mp < 2; ++mp) {
                const int c = cbase + 4 * ai + 2 * wr + mp;
                const size_t base = ((size_t)((b * 8 + h) * 64 + c)) * 4096;
#pragma unroll
                for (int n = 0; n < 2; ++n) {
                    float Gs[2][4], kk[2][4];
#pragma unroll
                    for (int mm = 0; mm < 2; ++mm)
#pragma unroll
                        for (int j = 0; j < 4; ++j) { const float lb = lb4[n][j]; const float f = lb + (1.f - lb) * sigm2(acc[ai][1][2 * mp + mm][n][j]);
                            kk[mm][j] = 1.f - f; Gs[mm][j] = scan16(__builtin_amdgcn_logf(f)); }
#pragma unroll
                    for (int j = 0; j < 4; ++j) Gs[1][j] += __shfl(Gs[0][j], 15, 16);
#pragma unroll
                    for (int mm = 0; mm < 2; ++mm) {
                        const int t = 16 * mm + fr;
                        float qt[4], kt[4];
#pragma unroll
                        for (int j = 0; j < 4; ++j) { const float q = acc[ai][0][2 * mp + mm][n][j]; qt[j] = q * sigm2(q) * ex2(Gs[mm][j]); kt[j] = kk[mm][j] * ex2(-Gs[mm][j]); }
                        const size_t o = base + ((size_t)((wc * 2 + n) * 64 + t + 32 * (fq & 1))) * 8 + 4 * (fq >> 1);
                        v2u w; w.x = pk2(qt[0], qt[1]); w.y = pk2(qt[2], qt[3]); *(v2u*)(FRQ + o) = w;
                        w.x = pk2(kt[0], kt[1]); w.y = pk2(kt[2], kt[3]); *(v2u*)(FRK + o) = w;
                        quad_transpose(kt, lane);
                        w.x = pk2(kt[0], kt[1]); w.y = pk2(kt[2], kt[3]);
                        *(v2u*)(FRKT + base + ((size_t)((wc * 2 + mm) * 64 + 16 * n + 4 * fq + (fr & 3) + 32 * hfs)) * 8 + j0s) = w;
                    }
                    if (fr == 15) *(f32x4*)(DEC + (size_t)(b * 64 + c) * 1024 + h * 128 + cin + 16 * n) = (f32x4){ex2(Gs[1][0]), ex2(Gs[1][1]), ex2(Gs[1][2]), ex2(Gs[1][3])};
                }
            }
    }
};

__device__ __forceinline__ int src_col(int mode, int np) {
    if (mode == 0) return np;
    if (mode == 1) { const int pn = np >> 8, cl = np & 255, bj = cl >> 7, wc = (cl >> 5) & 3, n = (cl >> 4) & 1, rest = cl & 15;
        return (2 * bj + n) * 1024 + 64 * pn + 16 * wc + rest; }
    const int pn = np >> 8, bj = (np >> 7) & 1, idx = np & 127;
    return pn < 8 ? bj * 1024 + 128 * pn + idx : 2048 + bj * 1024 + 128 * (pn - 8) + idx;
}
__device__ __forceinline__ void transpose_item(const float* W, int N, bf16* WT, int row_off, int mode, LAS float* scr, int item, int lane) {
    const int nblk = N / 32, kb = item / nblk, nb = item % nblk, k0 = 64 * kb, n0 = 32 * nb;
    const int sc = src_col(mode, n0 + (lane & 31));
#pragma unroll 8
    for (int i = 0; i < 32; ++i) { const int kk = 2 * i + (lane >> 5); scr[kk * 33 + (lane & 31)] = W[(size_t)(k0 + kk) * N + sc]; }
    LDS_WAIT(); asm volatile("" ::: "memory");
    const int c = lane & 7;
#pragma unroll
    for (int j = 0; j < 4; ++j) { const int n = (lane >> 3) + 8 * j; const LAS float* s = scr + (8 * c) * 33 + n;
        v4u o; o.x = pk2(s[0 * 33], s[1 * 33]); o.y = pk2(s[2 * 33], s[3 * 33]); o.z = pk2(s[4 * 33], s[5 * 33]); o.w = pk2(s[6 * 33], s[7 * 33]);
        *(v4u*)(WT + (size_t)(row_off + n0 + n) * 1024 + k0 + 8 * c) = o; }
    LDS_WAIT(); asm volatile("" ::: "memory");
}

__device__ __forceinline__ void phase_prologue(LAS unsigned char* lds, int G) {
    const KPtr p = kparams();
    const int tid = opaque_tid(), lane = tid & 63, wave = tid >> 6;
    const int gw = opaque_bid() * NWAVES + wave, NGW = G * NWAVES;
    LAS float* scr = (LAS float*)(lds + wave * 16384);
    unsigned char* ws = p->ws;
    constexpr int I_IN = 16 * 128, I_OUT = 16 * 32, I_ADA = 16 * 96;
    constexpr int NITEMS = 4 * I_IN + 4 * I_OUT + 4 * I_ADA;
    for (int it = gw; it < NITEMS; it += NGW) {
        int r = it;
        if (r < 4 * I_ADA) { const int l = r / I_ADA; transpose_item(p->w_ada + (size_t)l * 1024 * 3072, 3072, (bf16*)(ws + WS_WADA), l * 3072, 0, scr, r % I_ADA, lane); continue; } r -= 4 * I_ADA;
        if (r < 2 * I_IN) { const int j = r / I_IN; transpose_item(p->conv_w_in + (size_t)j * 1024 * 4096, 4096, (bf16*)(ws + WS_WCIN) + (size_t)j * 4096 * 1024, 0, 1, scr, r % I_IN, lane); continue; } r -= 2 * I_IN;
        if (r < 2 * I_IN) { const int j = r / I_IN; transpose_item(p->hgrn_w_in + (size_t)j * 1024 * 4096, 4096, (bf16*)(ws + WS_WHIN) + (size_t)j * 4096 * 1024, 0, 2, scr, r % I_IN, lane); continue; } r -= 2 * I_IN;
        if (r < 2 * I_OUT) { const int j = r / I_OUT; transpose_item(p->conv_w_out + (size_t)j * 1024 * 1024, 1024, (bf16*)(ws + WS_WCOUT) + (size_t)j * 1024 * 1024, 0, 0, scr, r % I_OUT, lane); continue; } r -= 2 * I_OUT;
        { const int j = r / I_OUT; transpose_item(p->hgrn_w_out + (size_t)j * 1024 * 1024, 1024, (bf16*)(ws + WS_WHOUT) + (size_t)j * 1024 * 1024, 0, 0, scr, r % I_OUT, lane); }
    }
    const int gt = opaque_bid() * NTHREADS + tid, NGT = G * NTHREADS;
    bf16* act = (bf16*)(ws + WS_ACT);
    for (int i = gt; i < 256 * 1024; i += NGT) { const int r = i >> 10, d = i & 1023;
        float v = 0.f; if (r < 8) v = siluf_(p->c_prompt[r * 1024 + d]); else if (r < 136) v = siluf_(p->c_sample[(r - 8) * 1024 + d]);
        act[i] = f2bf(v); }
    float* lbs = (float*)(ws + WS_LBS);
    for (int e = gt; e < 1024; e += NGT) {
        const float a0 = p->hgrn_lb[e], a1 = p->hgrn_lb[1024 + e], a2 = p->hgrn_lb[2048 + e], a3 = p->hgrn_lb[3072 + e];
        const float mx = fmaxf(fmaxf(a0, a1), fmaxf(a2, a3));
        const float e0 = __expf(a0 - mx), e1 = __expf(a1 - mx), e2 = __expf(a2 - mx), e3 = __expf(a3 - mx), inv = 1.f / (e0 + e1 + e2 + e3);
        lbs[e] = 0.f; lbs[1024 + e] = e1 * inv; lbs[2048 + e] = (e1 + e2) * inv; lbs[3072 + e] = (e1 + e2 + e3) * inv; }
}

__device__ __forceinline__ void phase_norm(int layer, int G) {
    const KPtr p = kparams();
    const int tid = opaque_tid(), lane = tid & 63, wave = tid >> 6;
    const int gw = opaque_bid() * NWAVES + wave, NGW = G * NWAVES;
    const float* mod = (const float*)(p->ws + WS_MOD) + layer * 3072;
    const float* X = p->out + O_Y;
    bf16* HB = (bf16*)(p->ws + WS_HB);
    const f32x4* g4 = (const f32x4*)(p->norm_g + layer * D) + lane;
    for (int r = gw; r < M; r += NGW) {
        const float* xrow = (layer == 0) ? (r < MP ? p->x_prompt + (size_t)r * D : p->x_sample + (size_t)(r - MP) * D) : X + (size_t)r * D;
        const f32x4* xr = (const f32x4*)xrow + lane;
        f32x4 v[4]; float s = 0.f;
#pragma unroll
        for (int j = 0; j < 4; ++j) { v[j] = xr[64 * j]; s += (v[j].x * v[j].x + v[j].y * v[j].y) + (v[j].z * v[j].z + v[j].w * v[j].w); }
        const float rstd = 1.f / sqrtf(wave_sum(s) * (1.f / D) + EPS);
        const float* mr = mod + (size_t)mod_row(r) * MODLD;
        const f32x4* sh4 = (const f32x4*)mr + lane; const f32x4* sc4 = (const f32x4*)(mr + 1024) + lane;
        v2u* o8 = (v2u*)(HB + (size_t)r * D) + lane;
#pragma unroll
        for (int j = 0; j < 4; ++j) { const f32x4 g = g4[64 * j], sh = sh4[64 * j], sc = sc4[64 * j];
            const f32x4 h = v[j] * rstd * g * (sc + 1.f) + sh;
            v2u w; w.x = pk2(h.x, h.y); w.y = pk2(h.z, h.w); o8[64 * j] = w; }
    }
}

__device__ __forceinline__ void phase_final(int G) {
    const KPtr p = kparams();
    const int tid = opaque_tid(), lane = tid & 63, wave = tid >> 6;
    const int gw = opaque_bid() * NWAVES + wave, NGW = G * NWAVES;
    float* X = p->out + O_Y;
    const f32x4* g4 = (const f32x4*)p->final_norm_g + lane;
    for (int r = gw; r < M; r += NGW) {
        f32x4* xr = (f32x4*)(X + (size_t)r * D) + lane;
        f32x4 v[4]; float s = 0.f;
#pragma unroll
        for (int j = 0; j < 4; ++j) { v[j] = xr[64 * j]; s += (v[j].x * v[j].x + v[j].y * v[j].y) + (v[j].z * v[j].z + v[j].w * v[j].w); }
        const float rstd = 1.f / sqrtf(wave_sum(s) * (1.f / D) + EPS);
#pragma unroll
        for (int j = 0; j < 4; ++j) xr[64 * j] = v[j] * rstd * g4[64 * j];
    }
}

__device__ __forceinline__ void bf8_to_f(const v4u w, float (&f)[8]) {
#pragma unroll
    for (int i = 0; i < 4; ++i) { f[2 * i] = __builtin_bit_cast(float, w[i] << 16); f[2 * i + 1] = __builtin_bit_cast(float, w[i] & 0xffff0000u); }
}
__device__ __forceinline__ void phase_conv_y(int j, int G) {
    const KPtr p = kparams();
    const int tid = opaque_tid();
    const bf16* U = (const bf16*)(p->ws + WS_U); const bf16* GB = (const bf16*)(p->ws + WS_GB);
    bf16* YB = (bf16*)(p->ws + WS_HB);
    const int e = (tid & 127) * 8;
    float w0[8], w1[8], w2[8];
    { const float* cw = p->conv_w + (size_t)j * 3 * 1024 + e;
#pragma unroll
      for (int i = 0; i < 8; ++i) { w0[i] = cw[i]; w1[i] = cw[1024 + i]; w2[i] = cw[2048 + i]; } }
    const float* st = p->state_conv + (size_t)j * 128 * 2 * 1024;
    for (int rg = opaque_bid(); rg < M / 4; rg += G) {
        const int r = rg * 4 + (tid >> 7);
        const bool samp = r >= MP; const int t = samp ? ((r - MP) & 3) : (r & 2047); const int seq = samp ? ((r - MP) >> 2) : (r >> 11);
        float g[8], u0[8], u1[8], u2[8];
        bf8_to_f(*(const v4u*)(GB + (size_t)r * D + e), g);
        bf8_to_f(*(const v4u*)(U + (size_t)r * D + e), u0);
        if (t >= 1) bf8_to_f(*(const v4u*)(U + (size_t)(r - 1) * D + e), u1);
        else if (samp) {
#pragma unroll
            for (int i = 0; i < 8; ++i) u1[i] = st[((size_t)seq * 2 + 1) * 1024 + e + i]; }
        else {
#pragma unroll
            for (int i = 0; i < 8; ++i) u1[i] = 0.f; }
        if (t >= 2) bf8_to_f(*(const v4u*)(U + (size_t)(r - 2) * D + e), u2);
        else if (samp) {
#pragma unroll
            for (int i = 0; i < 8; ++i) u2[i] = st[((size_t)seq * 2 + t) * 1024 + e + i]; }
        else {
#pragma unroll
            for (int i = 0; i < 8; ++i) u2[i] = 0.f; }
        v4u o;
#pragma unroll
        for (int i = 0; i < 4; ++i) o[i] = pk2(g[2 * i] * (w0[2 * i] * u2[2 * i] + w1[2 * i] * u1[2 * i] + w2[2 * i] * u0[2 * i]),
                                               g[2 * i + 1] * (w0[2 * i + 1] * u2[2 * i + 1] + w1[2 * i + 1] * u1[2 * i + 1] + w2[2 * i + 1] * u0[2 * i + 1]));
        *(v4u*)(YB + (size_t)r * D + e) = o;
    }
}

#define MFMA32(a, b, c) __builtin_amdgcn_mfma_f32_32x32x16_bf16((a), (b), (c), 0, 0, 0)
__device__ __forceinline__ bf16x8 pack8(const f32x16& x, int s) {
    v4u w; w.x = pk2(x[8 * s + 0], x[8 * s + 1]); w.y = pk2(x[8 * s + 2], x[8 * s + 3]); w.z = pk2(x[8 * s + 4], x[8 * s + 5]); w.w = pk2(x[8 * s + 6], x[8 * s + 7]);
    return __builtin_bit_cast(bf16x8, w);
}
constexpr int REC_SLOT = 33280, REC_KF = 8192, REC_KT = 16384, REC_VF = 24576, REC_D = 32768;
__device__ __forceinline__ void rec_issue(const unsigned char* gq, const unsigned char* gk, const unsigned char* gkt, const unsigned char* gv, const unsigned char* gd,
                                          LAS unsigned char* slot, int lw, int lane) {
    const unsigned char* src = lw == 0 ? gq : (lw == 1 ? gk : (lw == 2 ? gkt : gv));
    LAS unsigned char* dst = slot + lw * 8192;
#pragma unroll
    for (int f = 0; f < 8; ++f) __builtin_amdgcn_global_load_lds((const unsigned*)(src + f * 1024 + lane * 16), (LAS unsigned*)(dst + f * 1024), 16, 0, 0);
    if (lw == 0 && lane < 32) __builtin_amdgcn_global_load_lds((const unsigned*)(gd + lane * 16), (LAS unsigned*)(slot + REC_D), 16, 0, 0);
}
__device__ __forceinline__ void hgrn_prompt_block(int j, int item, LAS unsigned char* lds) {
    const KPtr p = kparams();
    const int tid = opaque_tid(), lane = tid & 63, wave = __builtin_amdgcn_readfirstlane(tid >> 6);
    const int b = item >> 3, h = item & 7;
    const size_t bh = (size_t)(b * 8 + h) * 64;
    if (wave >= 4) {
        const int lw = wave - 4;
        const unsigned char* gq = (const unsigned char*)(p->ws + WS_FRQ) + bh * 8192; const unsigned char* gk = (const unsigned char*)(p->ws + WS_FRK) + bh * 8192;
        const unsigned char* gkt = (const unsigned char*)(p->ws + WS_FRKT) + bh * 8192; const unsigned char* gv = (const unsigned char*)(p->ws + WS_FRV) + bh * 8192;
        const unsigned char* gd = (const unsigned char*)(p->ws + WS_DEC) + ((size_t)b * 64 * 1024 + h * 128) * 4;
#pragma unroll
        for (int c = 0; c < 3; ++c) rec_issue(gq + c * 8192, gk + c * 8192, gkt + c * 8192, gv + c * 8192, gd + c * 4096, lds + c * REC_SLOT, lw, lane);
        for (int c = 0; c < 64; ++c) {
            if (c < 61) { if (lw == 0) asm volatile("s_waitcnt vmcnt(18)" ::: "memory"); else asm volatile("s_waitcnt vmcnt(16)" ::: "memory"); }
            else asm volatile("s_waitcnt vmcnt(0)" ::: "memory");
            __builtin_amdgcn_s_barrier();
            asm volatile("" ::: "memory");
            if (c + 3 < 64) { const int cn = c + 3; rec_issue(gq + cn * 8192, gk + cn * 8192, gkt + cn * 8192, gv + cn * 8192, gd + cn * 4096, lds + (cn & 3) * REC_SLOT, lw, lane); }
        }
    } else {
        const int vs = wave, hf = lane >> 5, l31 = lane & 31;
        float* O = (float*)(p->ws + WS_OB);
        f32x16 S[4];
#pragma unroll
        for (int kt = 0; kt < 4; ++kt)
#pragma unroll
            for (int i = 0; i < 16; ++i) S[kt][i] = 0.f;
        for (int c = 0; c < 64; ++c) {
            __builtin_amdgcn_s_barrier();
            asm volatile("" ::: "memory");
            const LAS unsigned char* slot = lds + (c & 3) * REC_SLOT;
            const LAS bf16x8* qp = (const LAS bf16x8*)slot + lane; const LAS bf16x8* kp = (const LAS bf16x8*)(slot + REC_KF) + lane;
            const LAS bf16x8* ktp = (const LAS bf16x8*)(slot + REC_KT) + lane; const LAS bf16x8* vp = (const LAS bf16x8*)(slot + REC_VF) + vs * 128 + lane;
            const LAS float* dp = (const LAS float*)(slot + REC_D) + 4 * hf;
            bf16x8 QF[8], KF[8], VF[2];
#pragma unroll
            for (int f = 0; f < 8; ++f) { QF[f] = qp[f * 64]; KF[f] = kp[f * 64]; }
            VF[0] = vp[0]; VF[1] = vp[64];
            f32x16 at;
#pragma unroll
            for (int i = 0; i < 16; ++i) at[i] = 0.f;
#pragma unroll
            for (int f = 0; f < 8; ++f) at = MFMA32(KF[f], QF[f], at);
#pragma unroll
            for (int i = 0; i < 16; ++i) { const int s = (i & 3) + 8 * (i >> 2) + 4 * hf; at[i] = (s <= l31) ? at[i] : 0.f; }
            const bf16x8 atp0 = pack8(at, 0), atp1 = pack8(at, 1);
            f32x16 o;
#pragma unroll
            for (int i = 0; i < 16; ++i) o[i] = 0.f;
#pragma unroll
            for (int kt = 0; kt < 4; ++kt) { o = MFMA32(pack8(S[kt], 0), QF[kt * 2], o); o = MFMA32(pack8(S[kt], 1), QF[kt * 2 + 1], o); }
            o = MFMA32(VF[0], atp0, o); o = MFMA32(VF[1], atp1, o);
            float* orow = O + (size_t)(b * 2048 + c * 32 + l31) * D + 128 * h + 32 * vs + 4 * hf;
#pragma unroll
            for (int g = 0; g < 4; ++g) *(f32x4*)(orow + 8 * g) = (f32x4){o[4 * g], o[4 * g + 1], o[4 * g + 2], o[4 * g + 3]};
#pragma unroll
            for (int kt = 0; kt < 4; ++kt) {
                const bf16x8 k0 = ktp[(kt * 2) * 64], k1 = ktp[(kt * 2 + 1) * 64];
                S[kt] = MFMA32(k0, VF[0], S[kt]); S[kt] = MFMA32(k1, VF[1], S[kt]);
#pragma unroll
                for (int g = 0; g < 4; ++g) { const f32x4 d = *(const LAS f32x4*)(dp + 32 * kt + 8 * g);
                    S[kt][4 * g] *= d.x; S[kt][4 * g + 1] *= d.y; S[kt][4 * g + 2] *= d.z; S[kt][4 * g + 3] *= d.w; }
            }
            asm volatile("s_waitcnt lgkmcnt(0)" ::: "memory");
        }
        float* so = p->out + O_HGP + ((size_t)((j * 8 + b) * 8 + h)) * 16384 + 32 * vs + l31;
#pragma unroll
        for (int kt = 0; kt < 4; ++kt)
#pragma unroll
            for (int i = 0; i < 16; ++i) so[(size_t)(32 * kt + (i & 3) + 8 * (i >> 2) + 4 * hf) * 128] = S[kt][i];
    }
    __syncthreads();
}

__device__ __forceinline__ void hgrn_sample_item(int layer, int j, int item, LAS float* L) {
    const KPtr p = kparams();
    const int tid = opaque_tid(), lane = tid & 63, wave = tid >> 6;
    const int s = item >> 3, h = item & 7;
    const float* PROJ = (const float*)(p->ws + WS_SPROJ);
    float* OB = (float*)(p->ws + WS_OB);
    const float* lbs = (const float*)(p->ws + WS_LBS) + layer * 1024;
    LAS float* qe = L;
    LAS float* kd = L + 512;
    LAS float* egl = L + 1024;
    LAS float* vv = L + 1152;
    LAS float* Ap = L + 1664;
    LAS float* part = L + 1728;
    const size_t r0 = (size_t)(4 * s);
    if (tid < 128) {
        const int k = tid; const float lb = lbs[h * 128 + k];
        float sq[4], kk[4], Gt[4]; float Gc = 0.f;
#pragma unroll
        for (int t = 0; t < 4; ++t) { const float* pr = PROJ + (r0 + t) * NPROJ + 256 * h + k;
            const float q = pr[0], fp = pr[128]; const float f = lb + (1.f - lb) * sigmoidf_(fp);
            Gc += __logf(f); Gt[t] = Gc; sq[t] = siluf_(q); kk[t] = 1.f - f; }
#pragma unroll
        for (int t = 0; t < 4; ++t) { qe[t * 128 + k] = sq[t] * __expf(Gt[t]); kd[t * 128 + k] = kk[t] * __expf(Gt[3] - Gt[t]); }
        egl[k] = __expf(Gt[3]);
#pragma unroll
        for (int t = 0; t < 4; ++t)
#pragma unroll
            for (int u = 0; u < 4; ++u) { float a = (u <= t) ? sq[t] * kk[u] * __expf(Gt[t] - Gt[u]) : 0.f; a = wave_sum(a); if (lane == 0) Ap[wave * 16 + t * 4 + u] = a; }
    } else if (tid < 256) {
        const int v = tid - 128;
#pragma unroll
        for (int t = 0; t < 4; ++t) vv[t * 128 + v] = PROJ[(r0 + t) * NPROJ + 2048 + 256 * h + v];
    }
    __syncthreads();
    {
        const int kg = tid >> 5, vg = tid & 31;
        const float* S0 = p->state_hgrn + ((size_t)((j * 128 + s) * 8 + h)) * 16384;
        float* S1 = p->out + O_HGS + ((size_t)((j * 128 + s) * 8 + h)) * 16384;
        f32x4 po[4];
#pragma unroll
        for (int t = 0; t < 4; ++t) po[t] = (f32x4){0.f, 0.f, 0.f, 0.f};
        f32x4 v4[4];
#pragma unroll
        for (int t = 0; t < 4; ++t) v4[t] = *(const LAS f32x4*)(vv + t * 128 + 4 * vg);
#pragma unroll
        for (int i = 0; i < 8; ++i) {
            const int k = 8 * kg + i;
            const f32x4 s0 = *(const f32x4*)(S0 + (size_t)k * 128 + 4 * vg);
            f32x4 sn = s0 * egl[k];
#pragma unroll
            for (int t = 0; t < 4; ++t) { sn += v4[t] * kd[t * 128 + k]; po[t] += s0 * qe[t * 128 + k]; }
            *(f32x4*)(S1 + (size_t)k * 128 + 4 * vg) = sn;
        }
#pragma unroll
        for (int t = 0; t < 4; ++t) *(LAS f32x4*)(part + (kg * 4 + t) * 128 + 4 * vg) = po[t];
    }
    __syncthreads();
    {
        const int t = tid >> 7, v = tid & 127;
        float o = 0.f;
#pragma unroll
        for (int kg = 0; kg < 16; ++kg) o += part[(kg * 4 + t) * 128 + v];
#pragma unroll
        for (int u = 0; u < 4; ++u) if (u <= t) o += (Ap[t * 4 + u] + Ap[16 + t * 4 + u]) * vv[u * 128 + v];
        OB[(MP + r0 + t) * D + 128 * h + v] = o;
    }
    __syncthreads();
}

__device__ __forceinline__ void phase_hgrn_rec(int layer, int j, LAS unsigned char* lds, int G) {
    const int bid = opaque_bid();
    if (bid < 64) hgrn_prompt_block(j, bid, lds);
    else for (int item = bid - 64; item < 1024; item += G - 64) hgrn_sample_item(layer, j, item, (LAS float*)lds);
}

__device__ __forceinline__ void phase_hgrn_y(int j, int G) {
    const KPtr p = kparams();
    const int tid = opaque_tid(), lane = tid & 63, wave = tid >> 6;
    const int gw = opaque_bid() * NWAVES + wave, NGW = G * NWAVES;
    const float* OB = (const float*)(p->ws + WS_OB); const bf16* SZ = (const bf16*)(p->ws + WS_SZ);
    bf16* YB = (bf16*)(p->ws + WS_HB);
    const float* og = p->hgrn_onorm_g + (size_t)j * 1024;
    for (int r = gw; r < M; r += NGW) {
#pragma unroll
        for (int jj = 0; jj < 4; ++jj) {
            const int e = 4 * lane + 256 * jj;
            const f32x4 o = *(const f32x4*)(OB + (size_t)r * D + e), g = *(const f32x4*)(og + e);
            const v2u zz = *(const v2u*)(SZ + (size_t)r * D + e);
            const float z0 = __builtin_bit_cast(float, zz.x << 16), z1 = __builtin_bit_cast(float, zz.x & 0xffff0000u), z2 = __builtin_bit_cast(float, zz.y << 16), z3 = __builtin_bit_cast(float, zz.y & 0xffff0000u);
            float ss = (o.x * o.x + o.y * o.y) + (o.z * o.z + o.w * o.w);
#pragma unroll
            for (int m = 1; m < 32; m <<= 1) ss += __shfl_xor(ss, m);
            const float rs = 1.f / sqrtf(ss * (1.f / 128.f) + EPS);
            v2u w; w.x = pk2(o.x * rs * g.x * z0, o.y * rs * g.y * z1); w.y = pk2(o.z * rs * g.z * z2, o.w * rs * g.w * z3);
            *(v2u*)(YB + (size_t)r * D + e) = w;
        }
    }
}

__device__ __forceinline__ void phase_ada_gemm(LAS unsigned char* lds, int G) {
    const KPtr p = kparams(); unsigned char* ws = p->ws;
    pg8::Gemm g{(const pg8::bf16_t*)(ws + WS_ACT), (const pg8::bf16_t*)(ws + WS_WADA), 256, MODLD, 1024}; pg8::StaticOrder S; S.init(256, MODLD, G, opaque_bid());
    EpiStoreF32 E{(float*)(ws + WS_MOD), MODLD, p->b_ada};
    pg8::gemm_phase<EpiStoreF32, pg8::StaticOrder, true, true>(lds, g, S, E);
}
__device__ __forceinline__ void phase_in_gemm_conv(int j, LAS unsigned char* lds, int G) {
    const KPtr p = kparams(); unsigned char* ws = p->ws;
    const bf16* W = (const bf16*)(ws + WS_WCIN) + (size_t)j * 4096 * 1024;
    pg8::Gemm g{(const pg8::bf16_t*)(ws + WS_HB), W, M, NPROJ, 1024}; pg8::StaticOrder S; S.init(M, NPROJ, G, opaque_bid());
    EpiConv E{(bf16*)(ws + WS_U), (bf16*)(ws + WS_GB), p->out + O_CONVP + (size_t)j * 8 * 2 * 1024, p->out + O_CONVS + (size_t)j * 128 * 2 * 1024};
    pg8::gemm_phase<EpiConv, pg8::StaticOrder, true, true>(lds, g, S, E);
}
__device__ __forceinline__ void phase_in_gemm_hgrn(int layer, LAS unsigned char* lds, int G) {
    const KPtr p = kparams(); unsigned char* ws = p->ws;
    const bf16* W = (const bf16*)(ws + WS_WHIN) + (size_t)(layer >> 1) * 4096 * 1024;
    pg8::Gemm g{(const pg8::bf16_t*)(ws + WS_HB), W, M, NPROJ, 1024}; pg8::StaticOrder S; S.init(M, NPROJ, G, opaque_bid());
    EpiHgrn E{(bf16*)(ws + WS_FRQ), (bf16*)(ws + WS_FRK), (bf16*)(ws + WS_FRKT), (bf16*)(ws + WS_FRV), (bf16*)(ws + WS_SZ), (float*)(ws + WS_DEC), (float*)(ws + WS_SPROJ), (const float*)(ws + WS_LBS) + layer * 1024};
    pg8::gemm_phase<EpiHgrn, pg8::StaticOrder, true, true>(lds, g, S, E);
}
__device__ __forceinline__ void phase_out_gemm(int layer, LAS unsigned char* lds, int G) {
    const KPtr p = kparams(); unsigned char* ws = p->ws;
    const int j = layer >> 1;
    float* X = p->out + O_Y;
    const bf16* W = (const bf16*)(ws + ((layer & 1) ? WS_WHOUT : WS_WCOUT)) + (size_t)j * 1024 * 1024;
    pg8::Gemm g{(const pg8::bf16_t*)(ws + WS_HB), W, M, D, 1024}; pg8::StaticOrder S; S.init(M, D, G, opaque_bid());
    EpiResid E{layer == 0 ? p->x_prompt : X, layer == 0 ? p->x_sample : X + (size_t)MP * D, X, (const float*)(ws + WS_MOD) + layer * 3072 + 2048};
    pg8::gemm_phase<EpiResid, pg8::StaticOrder, true, true>(lds, g, S, E);
}

__global__ void __launch_bounds__(NTHREADS, 2) fwd_megakernel(Params p_unused) {
    extern __shared__ __attribute__((aligned(16))) unsigned char lds_raw[];
    LAS unsigned char* lds = (LAS unsigned char*)lds_raw;
    cg::grid_group grid = cg::this_grid();
    const int G = gridDim.x;

    phase_prologue(lds, G);
    grid.sync();
    phase_ada_gemm(lds, G);
    grid.sync();
#pragma unroll 1
    for (int layer = 0; layer < 4; ++layer) {
        const int j = layer >> 1; const bool is_conv = (layer & 1) == 0;
        phase_norm(layer, G);
        grid.sync();
        if (is_conv) { phase_in_gemm_conv(j, lds, G); grid.sync(); phase_conv_y(j, G); }
        else {
            phase_in_gemm_hgrn(layer, lds, G);
            grid.sync();
            phase_hgrn_rec(layer, j, lds, G);
            grid.sync();
            phase_hgrn_y(j, G);
        }
        grid.sync();
        phase_out_gemm(layer, lds, G);
        grid.sync();
    }
    phase_final(G);
}

extern "C" void kernel_launch(void* const* d_in, const int* in_sizes, int n_in, void* d_out, int out_size, void* d_ws, size_t ws_size, hipStream_t stream) {
    static int grid_blocks = 0;
    if (grid_blocks == 0) {
        if (n_in != 17 || ws_size < WS_END) { fprintf(stderr, "kernel_launch: unexpected n_in %d or ws_size %zu (< %zu)\n", n_in, ws_size, (size_t)WS_END); grid_blocks = -1; return; }
        int dev = 0, cus = 0, per_cu = 0;
        hipGetDevice(&dev);
        hipDeviceGetAttribute(&cus, hipDeviceAttributeMultiprocessorCount, dev);
        if (hipFuncSetAttribute((const void*)fwd_megakernel, hipFuncAttributeMaxDynamicSharedMemorySize, LDS_BYTES) != hipSuccess) { fprintf(stderr, "kernel_launch: hipFuncSetAttribute failed\n"); grid_blocks = -1; return; }
        hipOccupancyMaxActiveBlocksPerMultiprocessor(&per_cu, (const void*)fwd_megakernel, NTHREADS, LDS_BYTES);
        if (per_cu < 1) { fprintf(stderr, "kernel_launch: occupancy query returned %d\n", per_cu); per_cu = 1; }
        grid_blocks = cus * per_cu;
    }
    if (grid_blocks < 0) return;
    Params p{};
    p.x_prompt = (const float*)d_in[0]; p.x_sample = (const float*)d_in[1]; p.state_conv = (const float*)d_in[2]; p.state_hgrn = (const float*)d_in[3];
    p.c_prompt = (const float*)d_in[4]; p.c_sample = (const float*)d_in[5]; p.norm_g = (const float*)d_in[6]; p.w_ada = (const float*)d_in[7]; p.b_ada = (const float*)d_in[8];
    p.conv_w_in = (const float*)d_in[9]; p.conv_w = (const float*)d_in[10]; p.conv_w_out = (const float*)d_in[11]; p.hgrn_w_in = (const float*)d_in[12];
    p.hgrn_lb = (const float*)d_in[13]; p.hgrn_onorm_g = (const float*)d_in[14]; p.hgrn_w_out = (const float*)d_in[15]; p.final_norm_g = (const float*)d_in[16];
    p.out = (float*)d_out; p.ws = (unsigned char*)d_ws;
    void* args[] = {&p};
    hipError_t e = hipLaunchCooperativeKernel((const void*)fwd_megakernel, dim3(grid_blocks), dim3(NTHREADS), args, LDS_BYTES, stream);
    if (e != hipSuccess) fprintf(stderr, "cooperative launch failed: %s (grid %d)\n", hipGetErrorString(e), grid_blocks);
}
```

```cpp
#include <hip/hip_runtime.h>
#include <hip/hip_cooperative_groups.h>
#include <cstdio>
#include <cstdint>
namespace cg = cooperative_groups;
__device__ __forceinline__ int opaque_tid() { int t = (int)threadIdx.x; asm volatile("" : "+v"(t)); return t; }
__device__ __forceinline__ int opaque_bid() { int b = (int)blockIdx.x; asm volatile("" : "+s"(b)); return b; }
__device__ __forceinline__ int opaque_s(int x) { asm volatile("" : "+s"(x)); return x; }
namespace pg8 {
#define PG8_LAS __attribute__((address_space(3)))
typedef unsigned short bf16_t;
typedef short bf16x8 __attribute__((ext_vector_type(8)));
typedef float f32x4 __attribute__((ext_vector_type(4)));
typedef unsigned u32x4 __attribute__((ext_vector_type(4)));
constexpr int BM = 256, BK = 64, HALF = 128, HTB = HALF * BK * 2  , STAGE_BYTES = 8 * HTB, NXCD = 8, WGM = 8;

__host__ __device__ __forceinline__ int lds_byte(int r, int c) { const int st = (r >> 4) * 2 + (c >> 5), rr = r & 15, cc = c & 31, ob = rr * 64 + cc * 2; return st * 1024 + (ob ^ (((ob >> 9) & 1) << 5)); }
__host__ __device__ __forceinline__ void stage_rc(int b, int& R, int& C) { const int st = b / 1024, sb = b % 1024, swz = sb ^ (((sb >> 9) & 1) << 5); R = (st >> 1) * 16 + swz / 64; C = (st & 1) * 32 + (swz % 64) / 2; }
__host__ __device__ __forceinline__ int perm32(int rho) { const int n = rho >> 4, i = rho & 15; return 8 * (i >> 2) + 4 * n + (i & 3); }

struct Unit { int pm, pn; };
struct Gemm { const bf16_t* A; const bf16_t* Bt; int M, N, K; };

struct StaticOrder {
    int nM, nN, nwg, G, c;
    __host__ __device__ void init(int M, int N, int G_, int c_) { nM = M / BM; nN = N / BM; nwg = nM * nN; G = G_; c = c_; }
    __host__ __device__ bool next(int i, Unit& u) const {
        const long L = (long)i * G + c; if (L >= nwg) return false;
        int wgid = (int)L; { const int q = nwg / NXCD, r = nwg % NXCD, xcd = wgid % NXCD, off = wgid / NXCD; wgid = (xcd < r ? xcd * (q + 1) : r * (q + 1) + (xcd - r) * q) + off; }
        const int nig = WGM * nN, gid = wgid / nig, fm = gid * WGM, gsz = (nM - fm) < WGM ? (nM - fm) : WGM;
        u.pm = fm + ((wgid % nig) % gsz); u.pn = (wgid % nig) / gsz; return true;
    }
    __device__ __forceinline__ void a_ready(const Unit&) const {}
    __device__ __forceinline__ void done(const Unit&) const {}
};

__device__ __forceinline__ unsigned cvt_pk_bf16(float lo, float hi) { unsigned r; asm volatile("v_cvt_pk_bf16_f32 %0, %1, %2" : "=v"(r) : "v"(lo), "v"(hi)); return r; }
template <class Epi, class Sched, bool ALIGN_EPI = false, bool SP2 = false>
__device__ __forceinline__ void gemm_phase(PG8_LAS unsigned char* lds, const Gemm g, const Sched& S, const Epi& E) {
    const int tid = opaque_tid(), wid = __builtin_amdgcn_readfirstlane(tid >> 6), lane = tid & 63, wr = wid >> 2, wc = wid & 3, fr = lane & 15, fq = lane >> 4;
    const int K = g.K, nt = K / BK;
    unsigned voffA[2], voffB[2];
#pragma unroll
    for (int i = 0; i < 2; ++i) { int R, C; stage_rc(tid * 16 + i * 8192, R, C); const int Rb = Epi::PERM ? ((R & ~31) + perm32(R & 31)) : R;
        voffA[i] = (unsigned)(R * K + C) * 2u; voffB[i] = (unsigned)(Rb * K + C) * 2u; }
    const size_t kstep = (size_t)(BK * 2);
    const size_t hstep = (size_t)HALF * K * 2;
    const size_t tstep = 2 * hstep;
    const unsigned ldsw = (unsigned)wid * 1024u;
    const int aoff = lds_byte(wr * 64 + fr, fq * 8), boff = lds_byte(wc * 32 + fr, fq * 8);
#define PG8_SA(b, h) (((b) * 2 + (h)) * HTB)
#define PG8_SB(b, h) ((4 + (b) * 2 + (h)) * HTB)
#define PG8_STAGE(bufoff, gbase, voff) do { _Pragma("unroll") for (int _i = 0; _i < 2; ++_i) \
        __builtin_amdgcn_global_load_lds((const unsigned*)((const char*)(gbase) + (voff)[_i]), (PG8_LAS unsigned*)(lds + (bufoff) + ldsw + _i * 8192), 16, 0, 0); } while (0)
#define PG8_LDA(dst, b, h) do { _Pragma("unroll") for (int m = 0; m < 4; ++m) _Pragma("unroll") for (int k = 0; k < 2; ++k) dst[m][k] = *(const PG8_LAS bf16x8*)(lds + PG8_SA(b, h) + aoff + m * 2048 + k * 1024); } while (0)
#define PG8_LDB(dst, b, h) do { _Pragma("unroll") for (int n = 0; n < 2; ++n) _Pragma("unroll") for (int k = 0; k < 2; ++k) dst[n][k] = *(const PG8_LAS bf16x8*)(lds + PG8_SB(b, h) + boff + n * 2048 + k * 1024); } while (0)
#define PG8_MMA(ai, bj, At, Bt) do { __builtin_amdgcn_s_setprio(1); _Pragma("unroll") for (int m = 0; m < 4; ++m) _Pragma("unroll") for (int n = 0; n < 2; ++n) _Pragma("unroll") for (int k = 0; k < 2; ++k) \
        acc[ai][bj][m][n] = __builtin_amdgcn_mfma_f32_16x16x32_bf16(Bt[n][k], At[m][k], acc[ai][bj][m][n], 0, 0, 0); __builtin_amdgcn_s_setprio(0); } while (0)
#define PG8_WAIT_V(n) asm volatile("s_waitcnt vmcnt(" #n ")" ::: "memory")
#define PG8_WAIT_L(n) asm volatile("s_waitcnt lgkmcnt(" #n ")" ::: "memory")
#define PG8_BAR __builtin_amdgcn_s_barrier()
#define PG8_SCHED __builtin_amdgcn_sched_barrier(0)
    Unit cur, nxt; int ui = 0;
    if (!S.next(0, cur)) return;
    f32x4 acc[2][2][4][2];
#pragma unroll
    for (int a = 0; a < 2; ++a)
#pragma unroll
        for (int b = 0; b < 2; ++b)
#pragma unroll
            for (int m = 0; m < 4; ++m)
#pragma unroll
                for (int n = 0; n < 2; ++n) acc[a][b][m][n] = (f32x4){0.f, 0.f, 0.f, 0.f};
    bf16x8 At[4][2], B0[2][2], B1[2][2];
    const char* cA = (const char*)g.A + (size_t)cur.pm * tstep; const char* cB = (const char*)g.Bt + (size_t)cur.pn * tstep;
    S.a_ready(cur);
    if constexpr (SP2) {
        PG8_STAGE(PG8_SB(0, 0), cB, voffB); PG8_STAGE(PG8_SB(0, 1), cB + hstep, voffB); PG8_STAGE(PG8_SA(0, 0), cA, voffA); PG8_STAGE(PG8_SA(0, 1), cA + hstep, voffA);
        if (wr == 1) PG8_BAR;
        PG8_WAIT_V(2); PG8_BAR;
        PG8_STAGE(PG8_SB(1, 0), cB + kstep, voffB); PG8_STAGE(PG8_SA(1, 0), cA + kstep, voffA); PG8_STAGE(PG8_SB(1, 1), cB + hstep + kstep, voffB);
        PG8_WAIT_V(6); PG8_BAR;
    } else {
        PG8_STAGE(PG8_SB(0, 0), cB, voffB); PG8_STAGE(PG8_SA(0, 0), cA, voffA); PG8_STAGE(PG8_SB(0, 1), cB + hstep, voffB); PG8_STAGE(PG8_SA(0, 1), cA + hstep, voffA);
        if (wr == 1) PG8_BAR;
        PG8_WAIT_V(4); PG8_BAR;
        PG8_STAGE(PG8_SB(1, 0), cB + kstep, voffB); PG8_STAGE(PG8_SA(1, 0), cA + kstep, voffA); PG8_STAGE(PG8_SB(1, 1), cB + hstep + kstep, voffB);
        PG8_WAIT_V(6); PG8_BAR;
    }
    for (;;) {
        const bool has_next = S.next(ui + 1, nxt);
        const char* nA = has_next ? (const char*)g.A + (size_t)nxt.pm * tstep : cA; const char* nB = has_next ? (const char*)g.Bt + (size_t)nxt.pn * tstep : cB;
        for (int t = 0; t < nt; t += 2) {
            const bool last = (t == nt - 2);
            const char* a1 = cA + (size_t)(t + 1) * kstep;
            const char* a2 = last ? nA : cA + (size_t)(t + 2) * kstep; const char* b2 = last ? nB : cB + (size_t)(t + 2) * kstep;
            const char* a3 = a2 + kstep; const char* b3 = b2 + kstep;
            if (last && has_next) S.a_ready(nxt);
            if constexpr (SP2) {
            PG8_LDB(B0, 0, 0); PG8_LDB(B1, 0, 1); PG8_SCHED; PG8_LDA(At, 0, 0); PG8_STAGE(PG8_SA(1, 1), a1 + hstep, voffA);
            PG8_WAIT_V(8); PG8_WAIT_L(0); PG8_BAR; PG8_MMA(0, 0, At, B0); PG8_MMA(0, 1, At, B1); PG8_BAR; PG8_SCHED;
            PG8_LDA(At, 0, 1); PG8_STAGE(PG8_SB(0, 0), b2, voffB); PG8_STAGE(PG8_SB(0, 1), b2 + hstep, voffB); PG8_STAGE(PG8_SA(0, 0), a2, voffA);
            PG8_WAIT_V(8); PG8_WAIT_L(0); PG8_BAR; PG8_MMA(1, 0, At, B0); PG8_MMA(1, 1, At, B1); PG8_BAR; PG8_SCHED;
            PG8_LDB(B0, 1, 0); PG8_LDB(B1, 1, 1); PG8_SCHED; PG8_LDA(At, 1, 0); PG8_STAGE(PG8_SA(0, 1), a2 + hstep, voffA);
            PG8_WAIT_V(8); PG8_WAIT_L(0); PG8_BAR; PG8_MMA(0, 0, At, B0); PG8_MMA(0, 1, At, B1); PG8_BAR; PG8_SCHED;
            PG8_LDA(At, 1, 1); PG8_STAGE(PG8_SB(1, 0), b3, voffB); PG8_STAGE(PG8_SB(1, 1), b3 + hstep, voffB); PG8_STAGE(PG8_SA(1, 0), a3, voffA);
            PG8_WAIT_V(8); PG8_WAIT_L(0); PG8_BAR; PG8_MMA(1, 0, At, B0); PG8_MMA(1, 1, At, B1); PG8_BAR; PG8_SCHED;
            } else {
            PG8_LDB(B0, 0, 0); PG8_SCHED; PG8_LDA(At, 0, 0); PG8_STAGE(PG8_SA(1, 1), a1 + hstep, voffA);
            PG8_WAIT_L(8); PG8_BAR; PG8_WAIT_L(0); PG8_MMA(0, 0, At, B0); PG8_BAR; PG8_SCHED;
            PG8_LDB(B1, 0, 1); PG8_STAGE(PG8_SB(0, 0), b2, voffB);
            PG8_BAR; PG8_WAIT_L(0); PG8_MMA(0, 1, At, B1); PG8_BAR;
            PG8_LDA(At, 0, 1); PG8_STAGE(PG8_SA(0, 0), a2, voffA);
            PG8_BAR; PG8_WAIT_L(0); PG8_MMA(1, 0, At, B0); PG8_BAR; PG8_SCHED;
            PG8_STAGE(PG8_SB(0, 1), b2 + hstep, voffB);
            PG8_WAIT_V(6); PG8_BAR; PG8_MMA(1, 1, At, B1); PG8_BAR;
            PG8_LDB(B0, 1, 0); PG8_SCHED; PG8_LDA(At, 1, 0); PG8_STAGE(PG8_SA(0, 1), a2 + hstep, voffA);
            PG8_WAIT_L(8); PG8_BAR; PG8_WAIT_L(0); PG8_MMA(0, 0, At, B0); PG8_BAR; PG8_SCHED;
            PG8_LDB(B1, 1, 1); PG8_STAGE(PG8_SB(1, 0), b3, voffB);
            PG8_BAR; PG8_WAIT_L(0); PG8_MMA(0, 1, At, B1); PG8_BAR;
            PG8_LDA(At, 1, 1); PG8_STAGE(PG8_SA(1, 0), a3, voffA);
            PG8_BAR; PG8_WAIT_L(0); PG8_MMA(1, 0, At, B0); PG8_BAR; PG8_SCHED;
            PG8_STAGE(PG8_SB(1, 1), b3 + hstep, voffB);
            PG8_WAIT_V(6); PG8_BAR; PG8_MMA(1, 1, At, B1); PG8_BAR;
            }
        }
        if constexpr (ALIGN_EPI) { if (wr == 0) PG8_BAR; }
        if constexpr (!Epi::AFTER_DRAIN) { E(acc, cur, wr, wc, fr, fq); S.done(cur); }
        if (!has_next) break;
#pragma unroll
        for (int a = 0; a < 2; ++a)
#pragma unroll
            for (int b = 0; b < 2; ++b)
#pragma unroll
                for (int m = 0; m < 4; ++m)
#pragma unroll
                    for (int n = 0; n < 2; ++n) acc[a][b][m][n] = (f32x4){0.f, 0.f, 0.f, 0.f};
        cur = nxt; cA = nA; cB = nB; ++ui;
        if constexpr (ALIGN_EPI) { if (wr == 1) PG8_BAR; }
    }
    PG8_WAIT_V(0);
    if constexpr (!ALIGN_EPI) { if (wr == 0) PG8_BAR; }
    PG8_BAR;
    if constexpr (Epi::AFTER_DRAIN) { E.fused(acc, cur, wr, wc, fr, fq, lds, wid, lane); S.done(cur); }
#undef PG8_SA
#undef PG8_SB
#undef PG8_STAGE
#undef PG8_LDA
#undef PG8_LDB
#undef PG8_MMA
#undef PG8_WAIT_V
#undef PG8_WAIT_L
#undef PG8_BAR
#undef PG8_SCHED
}
}

constexpr int NWAVES = 8, NTHREADS = 512;
constexpr int D = 1024, MP = 16384, MS = 512, M = MP + MS, NPROJ = 4096;
constexpr int MODLD = 12288;
constexpr float EPS = 1e-6f;
constexpr size_t O_Y = 0, O_CONVP = 17301504, O_HGP = 17334272, O_CONVS = 19431424, O_HGS = 19955712;
constexpr size_t MiB = 1u << 20;
constexpr size_t WS_WCIN = 1 * MiB, WS_WHIN = 17 * MiB, WS_WCOUT = 33 * MiB, WS_WHOUT = 37 * MiB, WS_MOD = 41 * MiB, WS_ACT = 53 * MiB,
                 WS_LBS = 54 * MiB, WS_DEC = 55 * MiB, WS_HB = 57 * MiB, WS_FRQ = 90 * MiB, WS_FRK = 122 * MiB, WS_FRKT = 154 * MiB, WS_FRV = 186 * MiB,
                 WS_PROJ = 218 * MiB, WS_WADA = WS_PROJ, WS_U = WS_PROJ, WS_GB = WS_PROJ + 33 * MiB, WS_OB = WS_PROJ + 66 * MiB, WS_SZ = WS_PROJ + 132 * MiB, WS_SPROJ = WS_PROJ + 165 * MiB, WS_END = 482 * MiB;
constexpr int LDS_BYTES = 147456, LDS_MISC = LDS_BYTES - 64;
constexpr size_t WS_BAR = 4096;

#define LAS __attribute__((address_space(3)))
typedef unsigned short bf16;
typedef unsigned v4u __attribute__((ext_vector_type(4)));
typedef unsigned v2u __attribute__((ext_vector_type(2)));
typedef float f32x4 __attribute__((ext_vector_type(4)));
typedef float f32x2 __attribute__((ext_vector_type(2)));
typedef float f32x16 __attribute__((ext_vector_type(16)));
typedef short bf16x8 __attribute__((ext_vector_type(8)));
typedef __bf16 bf16x2n __attribute__((ext_vector_type(2)));
#define LDS_WAIT() asm volatile("s_waitcnt lgkmcnt(0)" ::: "memory")

__device__ __forceinline__ unsigned pk2(float lo, float hi) { f32x2 v = {lo, hi}; return __builtin_bit_cast(unsigned, __builtin_convertvector(v, bf16x2n)); }
__device__ __forceinline__ unsigned short f2bf(float f) { return (unsigned short)(pk2(f, 0.f) & 0xffffu); }
__device__ __forceinline__ float sigmoidf_(float x) { return 1.f / (1.f + __expf(-x)); }
__device__ __forceinline__ float siluf_(float x) { return x * sigmoidf_(x); }
__device__ __forceinline__ float wave_sum(float v) {
#pragma unroll
    for (int o = 1; o < 64; o <<= 1) v += __shfl_xor(v, o);
    return v;
}
__device__ __forceinline__ int mod_row(int r) { return r < MP ? (r >> 11) : 8 + ((r - MP) >> 2); }

#define XB_TMO      128
#define XB_XCNT(j)  (256  + 64 * (j))
#define XB_XSUB(j)  (1280 + 64 * (j))
#define XB_XGEN(j)  (2304 + 64 * (j))
#define XB_TOP      3328
#define XB_TOPGEN   3392
#define XCD_BAR_WORDS 3456
#define XB_SPIN_CAP (1u << 18)

__device__ __forceinline__ unsigned xb_ld(unsigned* p)              { return __hip_atomic_load(p, __ATOMIC_RELAXED, __HIP_MEMORY_SCOPE_AGENT); }
__device__ __forceinline__ unsigned xb_add(unsigned* p, unsigned v) { return __hip_atomic_fetch_add(p, v, __ATOMIC_RELAXED, __HIP_MEMORY_SCOPE_AGENT); }
__device__ __forceinline__ unsigned xb_xcc_id() { return (unsigned)__builtin_amdgcn_s_getreg((3 << 11) | 20) & 0xFu; }
#define XB_SPIN(cond, bar) do { unsigned _sp = 0; while (cond) { __builtin_amdgcn_s_sleep(1); \
    if ((++_sp & 255u) == 0u) { if (xb_ld(&(bar)[XB_TMO])) break; if (_sp > XB_SPIN_CAP) { atomicAdd(&(bar)[XB_TMO], 1u); break; } } } } while (0)

struct XcdBarrier {
    unsigned* bar; unsigned x;
    volatile LAS unsigned* st;
};

__device__ __forceinline__ XcdBarrier xcd_barrier_post(unsigned* bar, volatile LAS unsigned* st) {
    XcdBarrier b; b.bar = bar; b.x = xb_xcc_id(); b.st = st;
    if (threadIdx.x == 0) (void)xb_add(&bar[XB_XCNT(b.x)], 1u);
    return b;
}
__device__ __forceinline__ void xcd_barrier_complete(unsigned* bar, unsigned x, unsigned& nloc, unsigned& nx) {
    const unsigned G = gridDim.x * gridDim.y * gridDim.z;
    unsigned sum, cnt, mine, sp = 0u;
    for (;;) {
        sum = 0u; cnt = 0u; mine = 0u;
#pragma unroll
        for (unsigned j = 0; j < 16; ++j) { const unsigned c = xb_ld(&bar[XB_XCNT(j)]); sum += c; cnt += (c > 0u) ? 1u : 0u; mine = (j == x) ? c : mine; }
        if (sum == G) break;
        __builtin_amdgcn_s_sleep(1);
        if ((++sp & 255u) == 0u) { if (xb_ld(&bar[XB_TMO])) break; if (sp > XB_SPIN_CAP) { atomicAdd(&bar[XB_TMO], 1u); break; } }
    }
    nloc = mine > 0u ? mine : 1u; nx = cnt > 0u ? cnt : 1u;
}

__device__ __forceinline__ void xcd_barrier(const XcdBarrier& b) {
    asm volatile("s_waitcnt vmcnt(0)" ::: "memory");
    __syncthreads();
    if (threadIdx.x == 0) {
        unsigned* bar = b.bar;
        __builtin_amdgcn_s_waitcnt(0);
        unsigned nloc = b.st[0], nx = b.st[1];
        if (nloc == 0u) { xcd_barrier_complete(bar, b.x, nloc, nx); b.st[0] = nloc; b.st[1] = nx; }
        const unsigned old = xb_add(&bar[XB_XSUB(b.x)], 1u);
        const unsigned gen = old / nloc;
        if (old + 1u == (gen + 1u) * nloc) {
            __builtin_amdgcn_fence(__ATOMIC_RELEASE, "agent");
            asm volatile("s_waitcnt vmcnt(0)" ::: "memory");
            const unsigned og = xb_add(&bar[XB_TOP], 1u);
            const unsigned tg = og / nx;
            if (og + 1u == (tg + 1u) * nx) xb_add(&bar[XB_TOPGEN], 1u);
            else XB_SPIN(xb_ld(&bar[XB_TOPGEN]) == tg, bar);
            __builtin_amdgcn_fence(__ATOMIC_ACQUIRE, "agent");
            xb_add(&bar[XB_XGEN(b.x)], 1u);
            asm volatile("s_waitcnt vmcnt(0)" ::: "memory");
        } else {
            XB_SPIN(xb_ld(&bar[XB_XGEN(b.x)]) == gen, bar);
            __builtin_amdgcn_fence(__ATOMIC_ACQUIRE, "agent");
            asm volatile("s_waitcnt vmcnt(0)" ::: "memory");
        }
    }
    __syncthreads();
}


struct Params {
    const float* x_prompt; const float* x_sample; const float* state_conv; const float* state_hgrn;
    const float* c_prompt; const float* c_sample; const float* norm_g; const float* w_ada; const float* b_ada;
    const float* conv_w_in; const float* conv_w; const float* conv_w_out; const float* hgrn_w_in;
    const float* hgrn_lb; const float* hgrn_onorm_g; const float* hgrn_w_out; const float* final_norm_g;
    float* out; unsigned char* ws;
};


typedef const Params __attribute__((address_space(4))) * KPtr;
__device__ __forceinline__ KPtr kparams() { KPtr q = (KPtr)__builtin_amdgcn_kernarg_segment_ptr(); asm volatile("" : "+s"(q)); return q; }
#define KP(field) (kparams()->field)

struct EpiStoreF32 {
    static constexpr bool PERM = false, AFTER_DRAIN = false;
    float* C; int ldc; const float* bias;
    __device__ __forceinline__ void operator()(const f32x4 (&acc)[2][2][4][2], const pg8::Unit& u, int wr, int wc, int fr, int fq) const {
        const int row0 = u.pm * 256 + wr * 64 + fr, col0 = u.pn * 256 + wc * 32 + 4 * fq;
        f32x4 bv[2][2];
#pragma unroll
        for (int bj = 0; bj < 2; ++bj)
#pragma unroll
            for (int n = 0; n < 2; ++n) bv[bj][n] = bias ? *(const f32x4*)(bias + col0 + bj * 128 + n * 16) : (f32x4){0.f, 0.f, 0.f, 0.f};
#pragma unroll
        for (int ai = 0; ai < 2; ++ai)
#pragma unroll
            for (int m = 0; m < 4; ++m) { float* rowp = C + (size_t)(row0 + ai * 128 + m * 16) * ldc + col0;
#pragma unroll
                for (int bj = 0; bj < 2; ++bj)
#pragma unroll
                    for (int n = 0; n < 2; ++n) *(f32x4*)(rowp + bj * 128 + n * 16) = acc[ai][bj][m][n] + bv[bj][n]; }
    }
};
struct EpiResid {
    static constexpr bool PERM = false, AFTER_DRAIN = false;
    int layer;
    __device__ __forceinline__ void operator()(const f32x4 (&acc)[2][2][4][2], const pg8::Unit& u, int wr, int wc, int fr, int fq) const {
        const KPtr p = kparams();
        float* X = p->out + O_Y;
        const float* xp = layer == 0 ? p->x_prompt : X; const float* xs = layer == 0 ? p->x_sample : X + (size_t)MP * D;
        const float* gate = (const float*)(p->ws + WS_MOD) + layer * 3072 + 2048;
        const int row0 = u.pm * 256 + wr * 64 + fr, col0 = u.pn * 256 + wc * 32 + 4 * fq;
#pragma unroll
        for (int ai = 0; ai < 2; ++ai)
#pragma unroll
            for (int m = 0; m < 4; ++m) {
                const int r = row0 + ai * 128 + m * 16;
                const float* xo = (r < MP) ? xp + (size_t)r * D : xs + (size_t)(r - MP) * D;
                const float* gp = gate + (size_t)mod_row(r) * MODLD;
                float* xn = X + (size_t)r * D;
#pragma unroll
                for (int bj = 0; bj < 2; ++bj)
#pragma unroll
                    for (int n = 0; n < 2; ++n) { const int c = col0 + bj * 128 + n * 16;
                        const f32x4 xv = *(const f32x4*)(xo + c), gv = *(const f32x4*)(gp + c);
                        *(f32x4*)(xn + c) = xv + gv * acc[ai][bj][m][n]; } }
    }
};


__device__ __forceinline__ f32x4 silu4(f32x4 z) { return (f32x4){siluf_(z.x), siluf_(z.y), siluf_(z.z), siluf_(z.w)}; }
struct EpiConv {
    static constexpr bool PERM = false, AFTER_DRAIN = false;
    int j;
    __device__ __forceinline__ void operator()(const f32x4 (&acc)[2][2][4][2], const pg8::Unit& u, int wr, int wc, int fr, int fq) const {
        const KPtr p = kparams();
        bf16* U = (bf16*)(p->ws + WS_U); bf16* GB = (bf16*)(p->ws + WS_GB);
        float* convp = p->out + O_CONVP + (size_t)j * 8 * 2 * 1024; float* convs = p->out + O_CONVS + (size_t)j * 128 * 2 * 1024;
        const int row0 = u.pm * 256 + wr * 64 + fr, e0 = u.pn * 64 + wc * 16 + 4 * fq;
#pragma unroll
        for (int ai = 0; ai < 2; ++ai)
#pragma unroll
            for (int m = 0; m < 4; ++m) {
                const int r = row0 + ai * 128 + m * 16;
                const f32x4 u4 = acc[ai][0][m][1] * acc[ai][1][m][0];
                const f32x4 g4 = acc[ai][0][m][0] * silu4(acc[ai][1][m][1]);
                v2u w; w.x = pk2(u4.x, u4.y); w.y = pk2(u4.z, u4.w); *(v2u*)(U + (size_t)r * D + e0) = w;
                w.x = pk2(g4.x, g4.y); w.y = pk2(g4.z, g4.w); *(v2u*)(GB + (size_t)r * D + e0) = w;
                if (r < MP) { const int t = r & 2047; if (t >= 2046) *(f32x4*)(convp + ((size_t)(r >> 11) * 2 + (t - 2046)) * 1024 + e0) = u4; }
                else { const int t = (r - MP) & 3; if (t >= 2) *(f32x4*)(convs + ((size_t)((r - MP) >> 2) * 2 + (t - 2)) * 1024 + e0) = u4; }
            }
    }
};


template <int CTRL> __device__ __forceinline__ float dppf(float x) { return __builtin_bit_cast(float, __builtin_amdgcn_update_dpp(0, __builtin_bit_cast(int, x), CTRL, 0xf, 0xf, false)); }
__device__ __forceinline__ float scan16(float x) {
    x += dppf<0x111>(x); x += dppf<0x112>(x); x += dppf<0x114>(x); x += dppf<0x118>(x); return x;
}
__device__ __forceinline__ void quad_transpose(float (&x)[4], int lane) {
    const bool p0 = (lane & 1) != 0, p1 = (lane & 2) != 0;
#pragma unroll
    for (int c = 0; c < 4; c += 2) { const float send = p0 ? x[c] : x[c + 1]; const float recv = dppf<0xB1>(send); if (p0) x[c] = recv; else x[c + 1] = recv; }
#pragma unroll
    for (int c = 0; c < 2; ++c) { const float send = p1 ? x[c] : x[c + 2]; const float recv = dppf<0x4E>(send); if (p1) x[c] = recv; else x[c + 2] = recv; }
}
__device__ __forceinline__ float ex2(float x) { return __builtin_amdgcn_exp2f(x); }
__device__ __forceinline__ float sigm2(float x) { return __builtin_amdgcn_rcpf(1.f + ex2(-1.4426950408889634f * x)); }

struct EpiHgrn {
    static constexpr bool PERM = false, AFTER_DRAIN = false;
    int layer;
    __device__ __forceinline__ void operator()(const f32x4 (&acc)[2][2][4][2], const pg8::Unit& u, int wr, int wc, int fr, int fq) const {
        unsigned char* ws = kparams()->ws;
        bf16* FRQ = (bf16*)(ws + WS_FRQ); bf16* FRK = (bf16*)(ws + WS_FRK); bf16* FRKT = (bf16*)(ws + WS_FRKT); bf16* FRV = (bf16*)(ws + WS_FRV); bf16* SZ = (bf16*)(ws + WS_SZ);
        float* DEC = (float*)(ws + WS_DEC); float* SPROJ = (float*)(ws + WS_SPROJ); const float* lbs = (const float*)(ws + WS_LBS) + layer * 1024;
        const int h = u.pn & 7; const bool qf = u.pn < 8;
        const int lr0 = wr * 64 + fr, lane = fr + 16 * fq;
        const int cin = 32 * wc + 4 * fq;
        if (u.pm >= 64) {
            const int row0 = (u.pm - 64) * 256 + lr0;
#pragma unroll
            for (int ai = 0; ai < 2; ++ai)
#pragma unroll
                for (int m = 0; m < 4; ++m) { const int row = row0 + ai * 128 + m * 16; float* rp = SPROJ + (size_t)row * NPROJ + u.pn * 256 + cin;
#pragma unroll
                    for (int n = 0; n < 2; ++n) {
                        *(f32x4*)(rp + 16 * n) = acc[ai][0][m][n];
                        if (qf) *(f32x4*)(rp + 128 + 16 * n) = acc[ai][1][m][n];
                        else { const f32x4 z = acc[ai][1][m][n]; v2u w; w.x = pk2(siluf_(z.x), siluf_(z.y)); w.y = pk2(siluf_(z.z), siluf_(z.w));
                            *(v2u*)(SZ + (size_t)(MP + row) * D + h * 128 + cin + 16 * n) = w; } } }
            return;
        }
        const int b = u.pm >> 3, cbase = (u.pm & 7) * 8;
        const int hfs = (fr >> 2) & 1, j0s = 4 * (fr >> 3);
        if (!qf) {
#pragma unroll
            for (int ai = 0; ai < 2; ++ai)
#pragma unroll
                for (int m = 0; m < 4; ++m) {
                    const int r = u.pm * 256 + lr0 + ai * 128 + m * 16, c = cbase + 4 * ai + 2 * wr + (m >> 1);
                    const size_t base = ((size_t)((b * 8 + h) * 64 + c)) * 4096;
#pragma unroll
                    for (int n = 0; n < 2; ++n) {
                        const f32x4 z = acc[ai][1][m][n]; v2u w; w.x = pk2(siluf_(z.x), siluf_(z.y)); w.y = pk2(siluf_(z.z), siluf_(z.w));
                        *(v2u*)(SZ + (size_t)r * D + h * 128 + cin + 16 * n) = w;
                        float x[4] = {acc[ai][0][m][n].x, acc[ai][0][m][n].y, acc[ai][0][m][n].z, acc[ai][0][m][n].w};
                        quad_transpose(x, lane);
                        w.x = pk2(x[0], x[1]); w.y = pk2(x[2], x[3]);
                        *(v2u*)(FRV + base + ((size_t)((wc * 2 + (m & 1)) * 64 + 16 * n + 4 * fq + (fr & 3) + 32 * hfs)) * 8 + j0s) = w;
                    }
                }
            return;
        }
        f32x4 lb4[2];
#pragma unroll
        for (int n = 0; n < 2; ++n) lb4[n] = *(const f32x4*)(lbs + h * 128 + cin + 16 * n);
#pragma unroll
        for (int ai = 0; ai < 2; ++ai)
#pragma unroll
            for (int mp = 0; mp < 2; ++mp) {
                const int c = cbase + 4 * ai + 2 * wr + mp;
                const size_t base = ((size_t)((b * 8 + h) * 64 + c)) * 4096;
#pragma unroll
                for (int n = 0; n < 2; ++n) {
                    float Gs[2][4], kk[2][4];
#pragma unroll
                    for (int mm = 0; mm < 2; ++mm)
#pragma unroll
                        for (int j = 0; j < 4; ++j) { const float lb = lb4[n][j]; const float f = lb + (1.f - lb) * sigm2(acc[ai][1][2 * mp + mm][n][j]);
                            kk[mm][j] = 1.f - f; Gs[mm][j] = scan16(__builtin_amdgcn_logf(f)); }
#pragma unroll
                    for (int j = 0; j < 4; ++j) Gs[1][j] += __shfl(Gs[0][j], 15, 16);
#pragma unroll
                    for (int mm = 0; mm < 2; ++mm) {
                        const int t = 16 * mm + fr;
                        float qt[4], kt[4];
#pragma unroll
                        for (int j = 0; j < 4; ++j) { const float q = acc[ai][0][2 * mp + mm][n][j]; qt[j] = q * sigm2(q) * ex2(Gs[mm][j]); kt[j] = kk[mm][j] * ex2(-Gs[mm][j]); }
                        const size_t o = base + ((size_t)((wc * 2 + n) * 64 + t + 32 * (fq & 1))) * 8 + 4 * (fq >> 1);
                        v2u w; w.x = pk2(qt[0], qt[1]); w.y = pk2(qt[2], qt[3]); *(v2u*)(FRQ + o) = w;
                        w.x = pk2(kt[0], kt[1]); w.y = pk2(kt[2], kt[3]); *(v2u*)(FRK + o) = w;
                        quad_transpose(kt, lane);
                        w.x = pk2(kt[0], kt[1]); w.y = pk2(kt[2], kt[3]);
                        *(v2u*)(FRKT + base + ((size_t)((wc * 2 + mm) * 64 + 16 * n + 4 * fq + (fr & 3) + 32 * hfs)) * 8 + j0s) = w;
                    }
                    if (fr == 15) *(f32x4*)(DEC + (size_t)(b * 64 + c) * 1024 + h * 128 + cin + 16 * n) = (f32x4){ex2(Gs[1][0]), ex2(Gs[1][1]), ex2(Gs[1][2]), ex2(Gs[1][3])};
                }
            }
    }
};

__device__ __forceinline__ int src_col(int mode, int np) {
    if (mode == 0) return np;
    if (mode == 1) { const int pn = np >> 8, cl = np & 255, bj = cl >> 7, wc = (cl >> 5) & 3, n = (cl >> 4) & 1, rest = cl & 15;
        return (2 * bj + n) * 1024 + 64 * pn + 16 * wc + rest; }
    const int pn = np >> 8, bj = (np >> 7) & 1, idx = np & 127;
    return pn < 8 ? bj * 1024 + 128 * pn + idx : 2048 + bj * 1024 + 128 * (pn - 8) + idx;
}
__device__ __forceinline__ void transpose_item(const float* W, int N, bf16* WT, int row_off, int mode, LAS float* scr, int item, int lane) {
    const int nblk = N / 32, kb = item / nblk, nb = item % nblk, k0 = 64 * kb, n0 = 32 * nb;
    const int sc = src_col(mode, n0 + (lane & 31));
#pragma unroll 8
    for (int i = 0; i < 32; ++i) { const int kk = 2 * i + (lane >> 5); scr[kk * 33 + (lane & 31)] = W[(size_t)(k0 + kk) * N + sc]; }
    LDS_WAIT(); asm volatile("" ::: "memory");
    const int c = lane & 7;
#pragma unroll
    for (int j = 0; j < 4; ++j) { const int n = (lane >> 3) + 8 * j; const LAS float* s = scr + (8 * c) * 33 + n;
        v4u o; o.x = pk2(s[0 * 33], s[1 * 33]); o.y = pk2(s[2 * 33], s[3 * 33]); o.z = pk2(s[4 * 33], s[5 * 33]); o.w = pk2(s[6 * 33], s[7 * 33]);
        *(v4u*)(WT + (size_t)(row_off + n0 + n) * 1024 + k0 + 8 * c) = o; }
    LDS_WAIT(); asm volatile("" ::: "memory");
}

__device__ __forceinline__ void phase_prologue(LAS unsigned char* lds, int G) {
    const KPtr p = kparams();
    const int tid = opaque_tid(), lane = tid & 63, wave = tid >> 6;
    const int gw = opaque_bid() * NWAVES + wave, NGW = G * NWAVES;
    LAS float* scr = (LAS float*)(lds + wave * 16384);
    unsigned char* ws = p->ws;
    constexpr int I_IN = 16 * 128, I_OUT = 16 * 32, I_ADA = 16 * 96;
    constexpr int NITEMS = 4 * I_IN + 4 * I_OUT + 4 * I_ADA;
    for (int it = gw; it < NITEMS; it += NGW) {
        int r = it;
        if (r < 4 * I_ADA) { const int l = r / I_ADA; transpose_item(p->w_ada + (size_t)l * 1024 * 3072, 3072, (bf16*)(ws + WS_WADA), l * 3072, 0, scr, r % I_ADA, lane); continue; } r -= 4 * I_ADA;
        if (r < 2 * I_IN) { const int j = r / I_IN; transpose_item(p->conv_w_in + (size_t)j * 1024 * 4096, 4096, (bf16*)(ws + WS_WCIN) + (size_t)j * 4096 * 1024, 0, 1, scr, r % I_IN, lane); continue; } r -= 2 * I_IN;
        if (r < 2 * I_IN) { const int j = r / I_IN; transpose_item(p->hgrn_w_in + (size_t)j * 1024 * 4096, 4096, (bf16*)(ws + WS_WHIN) + (size_t)j * 4096 * 1024, 0, 2, scr, r % I_IN, lane); continue; } r -= 2 * I_IN;
        if (r < 2 * I_OUT) { const int j = r / I_OUT; transpose_item(p->conv_w_out + (size_t)j * 1024 * 1024, 1024, (bf16*)(ws + WS_WCOUT) + (size_t)j * 1024 * 1024, 0, 0, scr, r % I_OUT, lane); continue; } r -= 2 * I_OUT;
        { const int j = r / I_OUT; transpose_item(p->hgrn_w_out + (size_t)j * 1024 * 1024, 1024, (bf16*)(ws + WS_WHOUT) + (size_t)j * 1024 * 1024, 0, 0, scr, r % I_OUT, lane); }
    }
    const int gt = opaque_bid() * NTHREADS + tid, NGT = G * NTHREADS;
    bf16* act = (bf16*)(ws + WS_ACT);
    for (int i = gt; i < 256 * 1024; i += NGT) { const int r = i >> 10, d = i & 1023;
        float v = 0.f; if (r < 8) v = siluf_(p->c_prompt[r * 1024 + d]); else if (r < 136) v = siluf_(p->c_sample[(r - 8) * 1024 + d]);
        act[i] = f2bf(v); }
    float* lbs = (float*)(ws + WS_LBS);
    for (int e = gt; e < 1024; e += NGT) {
        const float a0 = p->hgrn_lb[e], a1 = p->hgrn_lb[1024 + e], a2 = p->hgrn_lb[2048 + e], a3 = p->hgrn_lb[3072 + e];
        const float mx = fmaxf(fmaxf(a0, a1), fmaxf(a2, a3));
        const float e0 = __expf(a0 - mx), e1 = __expf(a1 - mx), e2 = __expf(a2 - mx), e3 = __expf(a3 - mx), inv = 1.f / (e0 + e1 + e2 + e3);
        lbs[e] = 0.f; lbs[1024 + e] = e1 * inv; lbs[2048 + e] = (e1 + e2) * inv; lbs[3072 + e] = (e1 + e2 + e3) * inv; }
}

__device__ __forceinline__ void phase_norm(int layer, int G) {
    const KPtr p = kparams();
    const int tid = opaque_tid(), lane = tid & 63, wave = tid >> 6;
    const int gw = opaque_bid() * NWAVES + wave, NGW = G * NWAVES;
    const float* mod = (const float*)(p->ws + WS_MOD) + layer * 3072;
    const float* X = p->out + O_Y;
    bf16* HB = (bf16*)(p->ws + WS_HB);
    const f32x4* g4 = (const f32x4*)(p->norm_g + layer * D) + lane;
    for (int r = gw; r < M; r += NGW) {
        const float* xrow = (layer == 0) ? (r < MP ? p->x_prompt + (size_t)r * D : p->x_sample + (size_t)(r - MP) * D) : X + (size_t)r * D;
        const f32x4* xr = (const f32x4*)xrow + lane;
        f32x4 v[4]; float s = 0.f;
#pragma unroll
        for (int j = 0; j < 4; ++j) { v[j] = xr[64 * j]; s += (v[j].x * v[j].x + v[j].y * v[j].y) + (v[j].z * v[j].z + v[j].w * v[j].w); }
        const float rstd = 1.f / sqrtf(wave_sum(s) * (1.f / D) + EPS);
        const float* mr = mod + (size_t)mod_row(r) * MODLD;
        const f32x4* sh4 = (const f32x4*)mr + lane; const f32x4* sc4 = (const f32x4*)(mr + 1024) + lane;
        v2u* o8 = (v2u*)(HB + (size_t)r * D) + lane;
#pragma unroll
        for (int j = 0; j < 4; ++j) { const f32x4 g = g4[64 * j], sh = sh4[64 * j], sc = sc4[64 * j];
            const f32x4 h = v[j] * rstd * g * (sc + 1.f) + sh;
            v2u w; w.x = pk2(h.x, h.y); w.y = pk2(h.z, h.w); o8[64 * j] = w; }
    }
}

__device__ __forceinline__ void phase_final(int G) {
    const KPtr p = kparams();
    const int tid = opaque_tid(), lane = tid & 63, wave = tid >> 6;
    const int gw = opaque_bid() * NWAVES + wave, NGW = G * NWAVES;
    float* X = p->out + O_Y;
    const f32x4* g4 = (const f32x4*)p->final_norm_g + lane;
    for (int r = gw; r < M; r += NGW) {
        f32x4* xr = (f32x4*)(X + (size_t)r * D) + lane;
        f32x4 v[4]; float s = 0.f;
#pragma unroll
        for (int j = 0; j < 4; ++j) { v[j] = xr[64 * j]; s += (v[j].x * v[j].x + v[j].y * v[j].y) + (v[j].z * v[j].z + v[j].w * v[j].w); }
        const float rstd = 1.f / sqrtf(wave_sum(s) * (1.f / D) + EPS);
#pragma unroll
        for (int j = 0; j < 4; ++j) xr[64 * j] = v[j] * rstd * g4[64 * j];
    }
}

__device__ __forceinline__ void bf8_to_f(const v4u w, float (&f)[8]) {
#pragma unroll
    for (int i = 0; i < 4; ++i) { f[2 * i] = __builtin_bit_cast(float, w[i] << 16); f[2 * i + 1] = __builtin_bit_cast(float, w[i] & 0xffff0000u); }
}
__device__ __forceinline__ void phase_conv_y(int j, int G) {
    const KPtr p = kparams();
    const int tid = opaque_tid();
    const bf16* U = (const bf16*)(p->ws + WS_U); const bf16* GB = (const bf16*)(p->ws + WS_GB);
    bf16* YB = (bf16*)(p->ws + WS_HB);
    const int e = (tid & 127) * 8;
    float w0[8], w1[8], w2[8];
    { const float* cw = p->conv_w + (size_t)j * 3 * 1024 + e;
#pragma unroll
      for (int i = 0; i < 8; ++i) { w0[i] = cw[i]; w1[i] = cw[1024 + i]; w2[i] = cw[2048 + i]; } }
    const float* st = p->state_conv + (size_t)j * 128 * 2 * 1024;
    for (int rg = opaque_bid(); rg < M / 4; rg += G) {
        const int r = rg * 4 + (tid >> 7);
        const bool samp = r >= MP; const int t = samp ? ((r - MP) & 3) : (r & 2047); const int seq = samp ? ((r - MP) >> 2) : (r >> 11);
        float g[8], u0[8], u1[8], u2[8];
        bf8_to_f(*(const v4u*)(GB + (size_t)r * D + e), g);
        bf8_to_f(*(const v4u*)(U + (size_t)r * D + e), u0);
        if (t >= 1) bf8_to_f(*(const v4u*)(U + (size_t)(r - 1) * D + e), u1);
        else if (samp) {
#pragma unroll
            for (int i = 0; i < 8; ++i) u1[i] = st[((size_t)seq * 2 + 1) * 1024 + e + i]; }
        else {
#pragma unroll
            for (int i = 0; i < 8; ++i) u1[i] = 0.f; }
        if (t >= 2) bf8_to_f(*(const v4u*)(U + (size_t)(r - 2) * D + e), u2);
        else if (samp) {
#pragma unroll
            for (int i = 0; i < 8; ++i) u2[i] = st[((size_t)seq * 2 + t) * 1024 + e + i]; }
        else {
#pragma unroll
            for (int i = 0; i < 8; ++i) u2[i] = 0.f; }
        v4u o;
#pragma unroll
        for (int i = 0; i < 4; ++i) o[i] = pk2(g[2 * i] * (w0[2 * i] * u2[2 * i] + w1[2 * i] * u1[2 * i] + w2[2 * i] * u0[2 * i]),
                                               g[2 * i + 1] * (w0[2 * i + 1] * u2[2 * i + 1] + w1[2 * i + 1] * u1[2 * i + 1] + w2[2 * i + 1] * u0[2 * i + 1]));
        *(v4u*)(YB + (size_t)r * D + e) = o;
    }
}

#define MFMA32(a, b, c) __builtin_amdgcn_mfma_f32_32x32x16_bf16((a), (b), (c), 0, 0, 0)
__device__ __forceinline__ bf16x8 pack8(const f32x16& x, int s) {
    v4u w; w.x = pk2(x[8 * s + 0], x[8 * s + 1]); w.y = pk2(x[8 * s + 2], x[8 * s + 3]); w.z = pk2(x[8 * s + 4], x[8 * s + 5]); w.w = pk2(x[8 * s + 6], x[8 * s + 7]);
    return __builtin_bit_cast(bf16x8, w);
}
constexpr int REC_SLOT = 33280, REC_KF = 8192, REC_KT = 16384, REC_VF = 24576, REC_D = 32768;
__device__ __forceinline__ void rec_issue(const unsigned char* gq, const unsigned char* gk, const unsigned char* gkt, const unsigned char* gv, const unsigned char* gd,
                                          LAS unsigned char* slot, int lw, int lane) {
    const unsigned char* src = lw == 0 ? gq : (lw == 1 ? gk : (lw == 2 ? gkt : gv));
    LAS unsigned char* dst = slot + lw * 8192;
#pragma unroll
    for (int f = 0; f < 8; ++f) __builtin_amdgcn_global_load_lds((const unsigned*)(src + f * 1024 + lane * 16), (LAS unsigned*)(dst + f * 1024), 16, 0, 0);
    if (lw == 0 && lane < 32) __builtin_amdgcn_global_load_lds((const unsigned*)(gd + lane * 16), (LAS unsigned*)(slot + REC_D), 16, 0, 0);
}
__device__ __forceinline__ void hgrn_prompt_block(int j, int item, LAS unsigned char* lds) {
    const KPtr p = kparams();
    const int tid = opaque_tid(), lane = tid & 63, wave = __builtin_amdgcn_readfirstlane(tid >> 6);
    const int b = item >> 3, h = item & 7;
    const size_t bh = (size_t)(b * 8 + h) * 64;
    if (wave >= 4) {
        const int lw = wave - 4;
        const unsigned char* gq = (const unsigned char*)(p->ws + WS_FRQ) + bh * 8192; const unsigned char* gk = (const unsigned char*)(p->ws + WS_FRK) + bh * 8192;
        const unsigned char* gkt = (const unsigned char*)(p->ws + WS_FRKT) + bh * 8192; const unsigned char* gv = (const unsigned char*)(p->ws + WS_FRV) + bh * 8192;
        const unsigned char* gd = (const unsigned char*)(p->ws + WS_DEC) + ((size_t)b * 64 * 1024 + h * 128) * 4;
#pragma unroll
        for (int c = 0; c < 3; ++c) rec_issue(gq + c * 8192, gk + c * 8192, gkt + c * 8192, gv + c * 8192, gd + c * 4096, lds + c * REC_SLOT, lw, lane);
        for (int c = 0; c < 64; ++c) {
            if (c < 61) { if (lw == 0) asm volatile("s_waitcnt vmcnt(18)" ::: "memory"); else asm volatile("s_waitcnt vmcnt(16)" ::: "memory"); }
            else asm volatile("s_waitcnt vmcnt(0)" ::: "memory");
            __builtin_amdgcn_s_barrier();
            asm volatile("" ::: "memory");
            if (c + 3 < 64) { const int cn = c + 3; rec_issue(gq + cn * 8192, gk + cn * 8192, gkt + cn * 8192, gv + cn * 8192, gd + cn * 4096, lds + (cn & 3) * REC_SLOT, lw, lane); }
        }
    } else {
        const int vs = wave, hf = lane >> 5, l31 = lane & 31;
        float* O = (float*)(p->ws + WS_OB);
        f32x16 S[4];
#pragma unroll
        for (int kt = 0; kt < 4; ++kt)
#pragma unroll
            for (int i = 0; i < 16; ++i) S[kt][i] = 0.f;
        for (int c = 0; c < 64; ++c) {
            __builtin_amdgcn_s_barrier();
            asm volatile("" ::: "memory");
            const LAS unsigned char* slot = lds + (c & 3) * REC_SLOT;
            const LAS bf16x8* qp = (const LAS bf16x8*)slot + lane; const LAS bf16x8* kp = (const LAS bf16x8*)(slot + REC_KF) + lane;
            const LAS bf16x8* ktp = (const LAS bf16x8*)(slot + REC_KT) + lane; const LAS bf16x8* vp = (const LAS bf16x8*)(slot + REC_VF) + vs * 128 + lane;
            const LAS float* dp = (const LAS float*)(slot + REC_D) + 4 * hf;
            bf16x8 QF[8], KF[8], VF[2];
#pragma unroll
            for (int f = 0; f < 8; ++f) { QF[f] = qp[f * 64]; KF[f] = kp[f * 64]; }
            VF[0] = vp[0]; VF[1] = vp[64];
            f32x16 at;
#pragma unroll
            for (int i = 0; i < 16; ++i) at[i] = 0.f;
#pragma unroll
            for (int f = 0; f < 8; ++f) at = MFMA32(KF[f], QF[f], at);
#pragma unroll
            for (int i = 0; i < 16; ++i) { const int s = (i & 3) + 8 * (i >> 2) + 4 * hf; at[i] = (s <= l31) ? at[i] : 0.f; }
            const bf16x8 atp0 = pack8(at, 0), atp1 = pack8(at, 1);
            f32x16 o;
#pragma unroll
            for (int i = 0; i < 16; ++i) o[i] = 0.f;
#pragma unroll
            for (int kt = 0; kt < 4; ++kt) { o = MFMA32(pack8(S[kt], 0), QF[kt * 2], o); o = MFMA32(pack8(S[kt], 1), QF[kt * 2 + 1], o); }
            o = MFMA32(VF[0], atp0, o); o = MFMA32(VF[1], atp1, o);
            float* orow = O + (size_t)(b * 2048 + c * 32 + l31) * D + 128 * h + 32 * vs + 4 * hf;
#pragma unroll
            for (int g = 0; g < 4; ++g) *(f32x4*)(orow + 8 * g) = (f32x4){o[4 * g], o[4 * g + 1], o[4 * g + 2], o[4 * g + 3]};
#pragma unroll
            for (int kt = 0; kt < 4; ++kt) {
                const bf16x8 k0 = ktp[(kt * 2) * 64], k1 = ktp[(kt * 2 + 1) * 64];
                S[kt] = MFMA32(k0, VF[0], S[kt]); S[kt] = MFMA32(k1, VF[1], S[kt]);
#pragma unroll
                for (int g = 0; g < 4; ++g) { const f32x4 d = *(const LAS f32x4*)(dp + 32 * kt + 8 * g);
                    S[kt][4 * g] *= d.x; S[kt][4 * g + 1] *= d.y; S[kt][4 * g + 2] *= d.z; S[kt][4 * g + 3] *= d.w; }
            }
            asm volatile("s_waitcnt lgkmcnt(0)" ::: "memory");
        }
        float* so = p->out + O_HGP + ((size_t)((j * 8 + b) * 8 + h)) * 16384 + 32 * vs + l31;
#pragma unroll
        for (int kt = 0; kt < 4; ++kt)
#pragma unroll
            for (int i = 0; i < 16; ++i) so[(size_t)(32 * kt + (i & 3) + 8 * (i >> 2) + 4 * hf) * 128] = S[kt][i];
    }
    __syncthreads();
}

__device__ __forceinline__ void hgrn_sample_wave(int layer, int j, int item, LAS float* L, int lane) {
    const KPtr p = kparams();
    const int s = item >> 3, h = item & 7;
    const float* PROJ = (const float*)(p->ws + WS_SPROJ);
    float* OB = (float*)(p->ws + WS_OB);
    const float* lbs = (const float*)(p->ws + WS_LBS) + layer * 1024;
    LAS float* sc = L; LAS float* vv = L + 128 * 12;
    const size_t r0 = (size_t)(4 * s);
    const int vg = lane & 31, kh = lane >> 5;
    const float* S0 = p->state_hgrn + ((size_t)((j * 128 + s) * 8 + h)) * 16384 + (size_t)(kh * 64) * 128 + 4 * vg;
    float* S1 = p->out + O_HGS + ((size_t)((j * 128 + s) * 8 + h)) * 16384 + (size_t)(kh * 64) * 128 + 4 * vg;
    float A[4][4];
#pragma unroll
    for (int t = 0; t < 4; ++t)
#pragma unroll
        for (int u = 0; u < 4; ++u) A[t][u] = 0.f;
#pragma unroll
    for (int kk2 = 0; kk2 < 2; ++kk2) {
        const int k = lane + 64 * kk2; const float lb = lbs[h * 128 + k];
        float sq[4], kk[4], Gt[4]; float Gc = 0.f;
#pragma unroll
        for (int t = 0; t < 4; ++t) { const float* pr = PROJ + (r0 + t) * NPROJ + 256 * h + k;
            const float q = pr[0], fp = pr[128]; const float f = lb + (1.f - lb) * sigmoidf_(fp);
            Gc += __logf(f); Gt[t] = Gc; sq[t] = siluf_(q); kk[t] = 1.f - f;
            vv[t * 128 + k] = pr[2048]; }
#pragma unroll
        for (int t = 0; t < 4; ++t) { sc[k * 12 + t] = sq[t] * __expf(Gt[t]); sc[k * 12 + 4 + t] = kk[t] * __expf(Gt[3] - Gt[t]); }
        sc[k * 12 + 8] = __expf(Gt[3]);
#pragma unroll
        for (int t = 0; t < 4; ++t)
#pragma unroll
            for (int u = 0; u <= t; ++u) A[t][u] += sq[t] * kk[u] * __expf(Gt[t] - Gt[u]);
    }
#pragma unroll
    for (int t = 0; t < 4; ++t)
#pragma unroll
        for (int u = 0; u <= t; ++u) A[t][u] = wave_sum(A[t][u]);
    LDS_WAIT(); asm volatile("" ::: "memory");
    f32x4 v4[4], po[4];
#pragma unroll
    for (int t = 0; t < 4; ++t) { v4[t] = *(const LAS f32x4*)(vv + t * 128 + 4 * vg); po[t] = (f32x4){0.f, 0.f, 0.f, 0.f}; }
#pragma unroll 1
    for (int i0 = 0; i0 < 64; i0 += 8) {
        f32x4 s0[8];
#pragma unroll
        for (int i = 0; i < 8; ++i) s0[i] = *(const f32x4*)(S0 + (size_t)(i0 + i) * 128);
#pragma unroll
        for (int i = 0; i < 8; ++i) {
            const LAS f32x4* c4 = (const LAS f32x4*)(sc + (kh * 64 + i0 + i) * 12);
            const f32x4 qe = c4[0], kd = c4[1]; const float eg = c4[2].x;
            f32x4 sn = s0[i] * eg;
            sn += v4[0] * kd.x; sn += v4[1] * kd.y; sn += v4[2] * kd.z; sn += v4[3] * kd.w;
            po[0] += s0[i] * qe.x; po[1] += s0[i] * qe.y; po[2] += s0[i] * qe.z; po[3] += s0[i] * qe.w;
            *(f32x4*)(S1 + (size_t)(i0 + i) * 128) = sn;
        }
    }
#pragma unroll
    for (int t = 0; t < 4; ++t) { po[t].x += __shfl_xor(po[t].x, 32); po[t].y += __shfl_xor(po[t].y, 32); po[t].z += __shfl_xor(po[t].z, 32); po[t].w += __shfl_xor(po[t].w, 32); }
    if (kh == 0) {
#pragma unroll
        for (int t = 0; t < 4; ++t) { f32x4 o = po[t];
#pragma unroll
            for (int u = 0; u <= t; ++u) o += v4[u] * A[t][u];
            *(f32x4*)(OB + (MP + r0 + t) * D + 128 * h + 4 * vg) = o; }
    }
    LDS_WAIT(); asm volatile("" ::: "memory");
}

__device__ __forceinline__ void phase_hgrn_rec(int layer, int j, LAS unsigned char* lds, int G) {
    const int bid = opaque_bid();
    if (bid < 64) hgrn_prompt_block(j, bid, lds);
    else {
        const int tid = opaque_tid(), lane = tid & 63, wave = __builtin_amdgcn_readfirstlane(tid >> 6);
        const int nb = G - 64;
        for (int item = wave * nb + (bid - 64); item < 1024; item += 8 * nb) hgrn_sample_wave(layer, j, item, (LAS float*)(lds + wave * 8192), lane);
    }
}

__device__ __forceinline__ void phase_hgrn_y(int j, int G) {
    const KPtr p = kparams();
    const int tid = opaque_tid(), lane = tid & 63, wave = tid >> 6;
    const int gw = opaque_bid() * NWAVES + wave, NGW = G * NWAVES;
    const float* OB = (const float*)(p->ws + WS_OB); const bf16* SZ = (const bf16*)(p->ws + WS_SZ);
    bf16* YB = (bf16*)(p->ws + WS_HB);
    const float* og = p->hgrn_onorm_g + (size_t)j * 1024;
    for (int r = gw; r < M; r += NGW) {
#pragma unroll
        for (int jj = 0; jj < 4; ++jj) {
            const int e = 4 * lane + 256 * jj;
            const f32x4 o = *(const f32x4*)(OB + (size_t)r * D + e), g = *(const f32x4*)(og + e);
            const v2u zz = *(const v2u*)(SZ + (size_t)r * D + e);
            const float z0 = __builtin_bit_cast(float, zz.x << 16), z1 = __builtin_bit_cast(float, zz.x & 0xffff0000u), z2 = __builtin_bit_cast(float, zz.y << 16), z3 = __builtin_bit_cast(float, zz.y & 0xffff0000u);
            float ss = (o.x * o.x + o.y * o.y) + (o.z * o.z + o.w * o.w);
#pragma unroll
            for (int m = 1; m < 32; m <<= 1) ss += __shfl_xor(ss, m);
            const float rs = 1.f / sqrtf(ss * (1.f / 128.f) + EPS);
            v2u w; w.x = pk2(o.x * rs * g.x * z0, o.y * rs * g.y * z1); w.y = pk2(o.z * rs * g.z * z2, o.w * rs * g.w * z3);
            *(v2u*)(YB + (size_t)r * D + e) = w;
        }
    }
}

__device__ __forceinline__ void phase_ada_gemm(LAS unsigned char* lds, int G) {
    const KPtr p = kparams(); unsigned char* ws = p->ws;
    pg8::Gemm g{(const pg8::bf16_t*)(ws + WS_ACT), (const pg8::bf16_t*)(ws + WS_WADA), 256, MODLD, 1024}; pg8::StaticOrder S; S.init(256, MODLD, G, opaque_bid());
    EpiStoreF32 E{(float*)(ws + WS_MOD), MODLD, p->b_ada};
    pg8::gemm_phase<EpiStoreF32, pg8::StaticOrder, true, true>(lds, g, S, E);
}
__device__ __forceinline__ void phase_in_gemm_conv(int j, LAS unsigned char* lds, int G) {
    const KPtr p = kparams(); unsigned char* ws = p->ws;
    const bf16* W = (const bf16*)(ws + WS_WCIN) + (size_t)j * 4096 * 1024;
    pg8::Gemm g{(const pg8::bf16_t*)(ws + WS_HB), W, M, NPROJ, 1024}; pg8::StaticOrder S; S.init(M, NPROJ, G, opaque_bid());
    EpiConv E{j};
    pg8::gemm_phase<EpiConv, pg8::StaticOrder, true, true>(lds, g, S, E);
}
__device__ __forceinline__ void phase_in_gemm_hgrn(int layer, LAS unsigned char* lds, int G) {
    const KPtr p = kparams(); unsigned char* ws = p->ws;
    const bf16* W = (const bf16*)(ws + WS_WHIN) + (size_t)(layer >> 1) * 4096 * 1024;
    pg8::Gemm g{(const pg8::bf16_t*)(ws + WS_HB), W, M, NPROJ, 1024}; pg8::StaticOrder S; S.init(M, NPROJ, G, opaque_bid());
    EpiHgrn E{layer};
    pg8::gemm_phase<EpiHgrn, pg8::StaticOrder, true, true>(lds, g, S, E);
}
__device__ __forceinline__ void phase_out_gemm(int layer, LAS unsigned char* lds, int G) {
    const KPtr p = kparams(); unsigned char* ws = p->ws;
    const int j = layer >> 1;
    const bf16* W = (const bf16*)(ws + ((layer & 1) ? WS_WHOUT : WS_WCOUT)) + (size_t)j * 1024 * 1024;
    pg8::Gemm g{(const pg8::bf16_t*)(ws + WS_HB), W, M, D, 1024}; pg8::StaticOrder S; S.init(M, D, G, opaque_bid());
    EpiResid E{layer};
    pg8::gemm_phase<EpiResid, pg8::StaticOrder, true, true>(lds, g, S, E);
}

#ifndef DUP_LIGHT
#define DUP_LIGHT 0
#endif
#ifndef DUP_G1
#define DUP_G1 0
#endif
__global__ void __launch_bounds__(NTHREADS, 2) fwd_megakernel(Params p_unused) {
    extern __shared__ __attribute__((aligned(16))) unsigned char lds_raw[];
    LAS unsigned char* lds = (LAS unsigned char*)lds_raw;
    cg::grid_group grid = cg::this_grid();
    const int G = gridDim.x;
    unsigned* barw = (unsigned*)(kparams()->ws + WS_BAR);
    if (blockIdx.x == 0) for (int i = threadIdx.x; i < XCD_BAR_WORDS; i += NTHREADS) barw[i] = 0u;
    if (threadIdx.x < 16) ((LAS unsigned*)(lds + LDS_MISC))[threadIdx.x] = 0u;
    __syncthreads();

    for (int rep = 0; rep <= DUP_LIGHT; ++rep) { phase_prologue(lds, opaque_s(G)); __syncthreads(); }
    grid.sync();
    (void)xcd_barrier_post(barw, (volatile LAS unsigned*)(lds + LDS_MISC));
#define GRID_BAR() do { XcdBarrier bar_; bar_.bar = (unsigned*)(kparams()->ws + WS_BAR); bar_.x = xb_xcc_id(); bar_.st = (volatile LAS unsigned*)(lds + LDS_MISC); xcd_barrier(bar_); } while (0)
    for (int rep = 0; rep <= DUP_G1; ++rep) phase_ada_gemm(lds, opaque_s(G));
    GRID_BAR();
#pragma unroll 1
    for (int layer = 0; layer < 4; ++layer) {
        const int j = layer >> 1; const bool is_conv = (layer & 1) == 0;
        for (int rep = 0; rep <= DUP_LIGHT; ++rep) phase_norm(layer, opaque_s(G));
        GRID_BAR();
        if (is_conv) {
            for (int rep = 0; rep <= DUP_G1; ++rep) phase_in_gemm_conv(j, lds, opaque_s(G));
            GRID_BAR();
            for (int rep = 0; rep <= DUP_LIGHT; ++rep) phase_conv_y(j, opaque_s(G)); }
        else {
            for (int rep = 0; rep <= DUP_G1; ++rep) phase_in_gemm_hgrn(layer, lds, opaque_s(G));
            GRID_BAR();
            phase_hgrn_rec(layer, j, lds, G);
            GRID_BAR();
            for (int rep = 0; rep <= DUP_LIGHT; ++rep) phase_hgrn_y(j, opaque_s(G));
        }
        GRID_BAR();
        phase_out_gemm(layer, lds, G);
        GRID_BAR();
    }
    phase_final(G);
}

extern "C" void kernel_launch(void* const* d_in, const int* in_sizes, int n_in, void* d_out, int out_size, void* d_ws, size_t ws_size, hipStream_t stream) {
    static int grid_blocks = 0;
    if (grid_blocks == 0) {
        if (n_in != 17 || ws_size < WS_END) { fprintf(stderr, "kernel_launch: unexpected n_in %d or ws_size %zu (< %zu)\n", n_in, ws_size, (size_t)WS_END); grid_blocks = -1; return; }
        int dev = 0, cus = 0, per_cu = 0;
        hipGetDevice(&dev);
        hipDeviceGetAttribute(&cus, hipDeviceAttributeMultiprocessorCount, dev);
        if (hipFuncSetAttribute((const void*)fwd_megakernel, hipFuncAttributeMaxDynamicSharedMemorySize, LDS_BYTES) != hipSuccess) { fprintf(stderr, "kernel_launch: hipFuncSetAttribute failed\n"); grid_blocks = -1; return; }
        hipOccupancyMaxActiveBlocksPerMultiprocessor(&per_cu, (const void*)fwd_megakernel, NTHREADS, LDS_BYTES);
        if (per_cu < 1) { fprintf(stderr, "kernel_launch: occupancy query returned %d\n", per_cu); per_cu = 1; }
        grid_blocks = cus * per_cu;
    }
    if (grid_blocks < 0) return;
    Params p{};
    p.x_prompt = (const float*)d_in[0]; p.x_sample = (const float*)d_in[1]; p.state_conv = (const float*)d_in[2]; p.state_hgrn = (const float*)d_in[3];
    p.c_prompt = (const float*)d_in[4]; p.c_sample = (const float*)d_in[5]; p.norm_g = (const float*)d_in[6]; p.w_ada = (const float*)d_in[7]; p.b_ada = (const float*)d_in[8];
    p.conv_w_in = (const float*)d_in[9]; p.conv_w = (const float*)d_in[10]; p.conv_w_out = (const float*)d_in[11]; p.hgrn_w_in = (const float*)d_in[12];
    p.hgrn_lb = (const float*)d_in[13]; p.hgrn_onorm_g = (const float*)d_in[14]; p.hgrn_w_out = (const float*)d_in[15]; p.final_norm_g = (const float*)d_in[16];
    p.out = (float*)d_out; p.ws = (unsigned char*)d_ws;
    void* args[] = {&p};
    hipError_t e = hipLaunchCooperativeKernel((const void*)fwd_megakernel, dim3(grid_blocks), dim3(NTHREADS), args, LDS_BYTES, stream);
    if (e != hipSuccess) fprintf(stderr, "cooperative launch failed: %s (grid %d)\n", hipGetErrorString(e), grid_blocks);
}
```

```cpp
#include <hip/hip_runtime.h>
#include <hip/hip_cooperative_groups.h>
#include <cstdio>
#include <cstdint>
namespace cg = cooperative_groups;
__device__ __forceinline__ int opaque_tid() { int t = (int)threadIdx.x; asm volatile("" : "+v"(t)); return t; }
__device__ __forceinline__ int opaque_bid() { int b = (int)blockIdx.x; asm volatile("" : "+s"(b)); return b; }
__device__ __forceinline__ int opaque_s(int x) { asm volatile("" : "+s"(x)); return x; }
namespace pg8 {
#define PG8_LAS __attribute__((address_space(3)))
typedef unsigned short bf16_t;
typedef short bf16x8 __attribute__((ext_vector_type(8)));
typedef float f32x4 __attribute__((ext_vector_type(4)));
typedef unsigned u32x4 __attribute__((ext_vector_type(4)));
constexpr int BM = 256, BK = 64, HALF = 128, HTB = HALF * BK * 2  , STAGE_BYTES = 8 * HTB, NXCD = 8, WGM = 8;

__host__ __device__ __forceinline__ int lds_byte(int r, int c) { const int st = (r >> 4) * 2 + (c >> 5), rr = r & 15, cc = c & 31, ob = rr * 64 + cc * 2; return st * 1024 + (ob ^ (((ob >> 9) & 1) << 5)); }
__host__ __device__ __forceinline__ void stage_rc(int b, int& R, int& C) { const int st = b / 1024, sb = b % 1024, swz = sb ^ (((sb >> 9) & 1) << 5); R = (st >> 1) * 16 + swz / 64; C = (st & 1) * 32 + (swz % 64) / 2; }
__host__ __device__ __forceinline__ int perm32(int rho) { const int n = rho >> 4, i = rho & 15; return 8 * (i >> 2) + 4 * n + (i & 3); }

struct Unit { int pm, pn; };
struct Gemm { const bf16_t* A; const bf16_t* Bt; int M, N, K; };

struct StaticOrder {
    int nM, nN, nwg, G, c;
    __host__ __device__ void init(int M, int N, int G_, int c_) { nM = M / BM; nN = N / BM; nwg = nM * nN; G = G_; c = c_; }
    __host__ __device__ bool next(int i, Unit& u) const {
        const long L = (long)i * G + c; if (L >= nwg) return false;
        int wgid = (int)L; { const int q = nwg / NXCD, r = nwg % NXCD, xcd = wgid % NXCD, off = wgid / NXCD; wgid = (xcd < r ? xcd * (q + 1) : r * (q + 1) + (xcd - r) * q) + off; }
        const int nig = WGM * nN, gid = wgid / nig, fm = gid * WGM, gsz = (nM - fm) < WGM ? (nM - fm) : WGM;
        u.pm = fm + ((wgid % nig) % gsz); u.pn = (wgid % nig) / gsz; return true;
    }
    __device__ __forceinline__ void a_ready(const Unit&) const {}
    __device__ __forceinline__ void done(const Unit&) const {}
};

__device__ __forceinline__ unsigned cvt_pk_bf16(float lo, float hi) { unsigned r; asm volatile("v_cvt_pk_bf16_f32 %0, %1, %2" : "=v"(r) : "v"(lo), "v"(hi)); return r; }
template <class Epi, class Sched, bool ALIGN_EPI = false, bool SP2 = false>
__device__ __forceinline__ void gemm_phase(PG8_LAS unsigned char* lds, const Gemm g, const Sched& S, const Epi& E) {
    const int tid = opaque_tid(), wid = __builtin_amdgcn_readfirstlane(tid >> 6), lane = tid & 63, wr = wid >> 2, wc = wid & 3, fr = lane & 15, fq = lane >> 4;
    const int K = g.K, nt = K / BK;
    unsigned voffA[2], voffB[2];
#pragma unroll
    for (int i = 0; i < 2; ++i) { int R, C; stage_rc(tid * 16 + i * 8192, R, C); const int Rb = Epi::PERM ? ((R & ~31) + perm32(R & 31)) : R;
        voffA[i] = (unsigned)(R * K + C) * 2u; voffB[i] = (unsigned)(Rb * K + C) * 2u; }
    const size_t kstep = (size_t)(BK * 2);
    const size_t hstep = (size_t)HALF * K * 2;
    const size_t tstep = 2 * hstep;
    const unsigned ldsw = (unsigned)wid * 1024u;
    const int aoff = lds_byte(wr * 64 + fr, fq * 8), boff = lds_byte(wc * 32 + fr, fq * 8);
#define PG8_SA(b, h) (((b) * 2 + (h)) * HTB)
#define PG8_SB(b, h) ((4 + (b) * 2 + (h)) * HTB)
#define PG8_STAGE(bufoff, gbase, voff) do { _Pragma("unroll") for (int _i = 0; _i < 2; ++_i) \
        __builtin_amdgcn_global_load_lds((const unsigned*)((const char*)(gbase) + (voff)[_i]), (PG8_LAS unsigned*)(lds + (bufoff) + ldsw + _i * 8192), 16, 0, 0); } while (0)
#define PG8_LDA(dst, b, h) do { _Pragma("unroll") for (int m = 0; m < 4; ++m) _Pragma("unroll") for (int k = 0; k < 2; ++k) dst[m][k] = *(const PG8_LAS bf16x8*)(lds + PG8_SA(b, h) + aoff + m * 2048 + k * 1024); } while (0)
#define PG8_LDB(dst, b, h) do { _Pragma("unroll") for (int n = 0; n < 2; ++n) _Pragma("unroll") for (int k = 0; k < 2; ++k) dst[n][k] = *(const PG8_LAS bf16x8*)(lds + PG8_SB(b, h) + boff + n * 2048 + k * 1024); } while (0)
#define PG8_MMA(ai, bj, At, Bt) do { __builtin_amdgcn_s_setprio(1); _Pragma("unroll") for (int m = 0; m < 4; ++m) _Pragma("unroll") for (int n = 0; n < 2; ++n) _Pragma("unroll") for (int k = 0; k < 2; ++k) \
        acc[ai][bj][m][n] = __builtin_amdgcn_mfma_f32_16x16x32_bf16(Bt[n][k], At[m][k], acc[ai][bj][m][n], 0, 0, 0); __builtin_amdgcn_s_setprio(0); } while (0)
#define PG8_WAIT_V(n) asm volatile("s_waitcnt vmcnt(" #n ")" ::: "memory")
#define PG8_WAIT_L(n) asm volatile("s_waitcnt lgkmcnt(" #n ")" ::: "memory")
#define PG8_BAR __builtin_amdgcn_s_barrier()
#define PG8_SCHED __builtin_amdgcn_sched_barrier(0)
    Unit cur, nxt; int ui = 0;
    if (!S.next(0, cur)) return;
    f32x4 acc[2][2][4][2];
#pragma unroll
    for (int a = 0; a < 2; ++a)
#pragma unroll
        for (int b = 0; b < 2; ++b)
#pragma unroll
            for (int m = 0; m < 4; ++m)
#pragma unroll
                for (int n = 0; n < 2; ++n) acc[a][b][m][n] = (f32x4){0.f, 0.f, 0.f, 0.f};
    bf16x8 At[4][2], B0[2][2], B1[2][2];
    const char* cA = (const char*)g.A + (size_t)cur.pm * tstep; const char* cB = (const char*)g.Bt + (size_t)cur.pn * tstep;
    S.a_ready(cur);
    if constexpr (SP2) {
        PG8_STAGE(PG8_SB(0, 0), cB, voffB); PG8_STAGE(PG8_SB(0, 1), cB + hstep, voffB); PG8_STAGE(PG8_SA(0, 0), cA, voffA); PG8_STAGE(PG8_SA(0, 1), cA + hstep, voffA);
        if (wr == 1) PG8_BAR;
        PG8_WAIT_V(2); PG8_BAR;
        PG8_STAGE(PG8_SB(1, 0), cB + kstep, voffB); PG8_STAGE(PG8_SA(1, 0), cA + kstep, voffA); PG8_STAGE(PG8_SB(1, 1), cB + hstep + kstep, voffB);
        PG8_WAIT_V(6); PG8_BAR;
    } else {
        PG8_STAGE(PG8_SB(0, 0), cB, voffB); PG8_STAGE(PG8_SA(0, 0), cA, voffA); PG8_STAGE(PG8_SB(0, 1), cB + hstep, voffB); PG8_STAGE(PG8_SA(0, 1), cA + hstep, voffA);
        if (wr == 1) PG8_BAR;
        PG8_WAIT_V(4); PG8_BAR;
        PG8_STAGE(PG8_SB(1, 0), cB + kstep, voffB); PG8_STAGE(PG8_SA(1, 0), cA + kstep, voffA); PG8_STAGE(PG8_SB(1, 1), cB + hstep + kstep, voffB);
        PG8_WAIT_V(6); PG8_BAR;
    }
    for (;;) {
        const bool has_next = S.next(ui + 1, nxt);
        const char* nA = has_next ? (const char*)g.A + (size_t)nxt.pm * tstep : cA; const char* nB = has_next ? (const char*)g.Bt + (size_t)nxt.pn * tstep : cB;
        for (int t = 0; t < nt; t += 2) {
            const bool last = (t == nt - 2);
            const char* a1 = cA + (size_t)(t + 1) * kstep;
            const char* a2 = last ? nA : cA + (size_t)(t + 2) * kstep; const char* b2 = last ? nB : cB + (size_t)(t + 2) * kstep;
            const char* a3 = a2 + kstep; const char* b3 = b2 + kstep;
            if (last && has_next) S.a_ready(nxt);
            if constexpr (SP2) {
            PG8_LDB(B0, 0, 0); PG8_LDB(B1, 0, 1); PG8_SCHED; PG8_LDA(At, 0, 0); PG8_STAGE(PG8_SA(1, 1), a1 + hstep, voffA);
            PG8_WAIT_V(8); PG8_WAIT_L(0); PG8_BAR; PG8_MMA(0, 0, At, B0); PG8_MMA(0, 1, At, B1); PG8_BAR; PG8_SCHED;
            PG8_LDA(At, 0, 1); PG8_STAGE(PG8_SB(0, 0), b2, voffB); PG8_STAGE(PG8_SB(0, 1), b2 + hstep, voffB); PG8_STAGE(PG8_SA(0, 0), a2, voffA);
            PG8_WAIT_V(8); PG8_WAIT_L(0); PG8_BAR; PG8_MMA(1, 0, At, B0); PG8_MMA(1, 1, At, B1); PG8_BAR; PG8_SCHED;
            PG8_LDB(B0, 1, 0); PG8_LDB(B1, 1, 1); PG8_SCHED; PG8_LDA(At, 1, 0); PG8_STAGE(PG8_SA(0, 1), a2 + hstep, voffA);
            PG8_WAIT_V(8); PG8_WAIT_L(0); PG8_BAR; PG8_MMA(0, 0, At, B0); PG8_MMA(0, 1, At, B1); PG8_BAR; PG8_SCHED;
            PG8_LDA(At, 1, 1); PG8_STAGE(PG8_SB(1, 0), b3, voffB); PG8_STAGE(PG8_SB(1, 1), b3 + hstep, voffB); PG8_STAGE(PG8_SA(1, 0), a3, voffA);
            PG8_WAIT_V(8); PG8_WAIT_L(0); PG8_BAR; PG8_MMA(1, 0, At, B0); PG8_MMA(1, 1, At, B1); PG8_BAR; PG8_SCHED;
            } else {
            PG8_LDB(B0, 0, 0); PG8_SCHED; PG8_LDA(At, 0, 0); PG8_STAGE(PG8_SA(1, 1), a1 + hstep, voffA);
            PG8_WAIT_L(8); PG8_BAR; PG8_WAIT_L(0); PG8_MMA(0, 0, At, B0); PG8_BAR; PG8_SCHED;
            PG8_LDB(B1, 0, 1); PG8_STAGE(PG8_SB(0, 0), b2, voffB);
            PG8_BAR; PG8_WAIT_L(0); PG8_MMA(0, 1, At, B1); PG8_BAR;
            PG8_LDA(At, 0, 1); PG8_STAGE(PG8_SA(0, 0), a2, voffA);
            PG8_BAR; PG8_WAIT_L(0); PG8_MMA(1, 0, At, B0); PG8_BAR; PG8_SCHED;
            PG8_STAGE(PG8_SB(0, 1), b2 + hstep, voffB);
            PG8_WAIT_V(6); PG8_BAR; PG8_MMA(1, 1, At, B1); PG8_BAR;
            PG8_LDB(B0, 1, 0); PG8_SCHED; PG8_LDA(At, 1, 0); PG8_STAGE(PG8_SA(0, 1), a2 + hstep, voffA);
            PG8_WAIT_L(8); PG8_BAR; PG8_WAIT_L(0); PG8_MMA(0, 0, At, B0); PG8_BAR; PG8_SCHED;
            PG8_LDB(B1, 1, 1); PG8_STAGE(PG8_SB(1, 0), b3, voffB);
            PG8_BAR; PG8_WAIT_L(0); PG8_MMA(0, 1, At, B1); PG8_BAR;
            PG8_LDA(At, 1, 1); PG8_STAGE(PG8_SA(1, 0), a3, voffA);
            PG8_BAR; PG8_WAIT_L(0); PG8_MMA(1, 0, At, B0); PG8_BAR; PG8_SCHED;
            PG8_STAGE(PG8_SB(1, 1), b3 + hstep, voffB);
            PG8_WAIT_V(6); PG8_BAR; PG8_MMA(1, 1, At, B1); PG8_BAR;
            }
        }
        if constexpr (ALIGN_EPI) { if (wr == 0) PG8_BAR; }
        if constexpr (!Epi::AFTER_DRAIN) { E(acc, cur, wr, wc, fr, fq); S.done(cur); }
        if (!has_next) break;
#pragma unroll
        for (int a = 0; a < 2; ++a)
#pragma unroll
            for (int b = 0; b < 2; ++b)
#pragma unroll
                for (int m = 0; m < 4; ++m)
#pragma unroll
                    for (int n = 0; n < 2; ++n) acc[a][b][m][n] = (f32x4){0.f, 0.f, 0.f, 0.f};
        cur = nxt; cA = nA; cB = nB; ++ui;
        if constexpr (ALIGN_EPI) { if (wr == 1) PG8_BAR; }
    }
    PG8_WAIT_V(0);
    if constexpr (!ALIGN_EPI) { if (wr == 0) PG8_BAR; }
    PG8_BAR;
    if constexpr (Epi::AFTER_DRAIN) { E.fused(acc, cur, wr, wc, fr, fq, lds, wid, lane); S.done(cur); }
#undef PG8_SA
#undef PG8_SB
#undef PG8_STAGE
#undef PG8_LDA
#undef PG8_LDB
#undef PG8_MMA
#undef PG8_WAIT_V
#undef PG8_WAIT_L
#undef PG8_BAR
#undef PG8_SCHED
}
}

constexpr int NWAVES = 8, NTHREADS = 512;
constexpr int D = 1024, MP = 16384, MS = 512, M = MP + MS, NPROJ = 4096;
constexpr int MODLD = 12288;
constexpr float EPS = 1e-6f;
constexpr size_t O_Y = 0, O_CONVP = 17301504, O_HGP = 17334272, O_CONVS = 19431424, O_HGS = 19955712;
constexpr size_t MiB = 1u << 20;
constexpr size_t WS_WCIN = 1 * MiB, WS_WHIN = 17 * MiB, WS_WCOUT = 33 * MiB, WS_WHOUT = 37 * MiB, WS_MOD = 41 * MiB, WS_ACT = 53 * MiB,
                 WS_LBS = 54 * MiB, WS_DEC = 55 * MiB, WS_HB = 57 * MiB, WS_FRQ = 90 * MiB, WS_FRK = 122 * MiB, WS_FRKT = 154 * MiB, WS_FRV = 186 * MiB,
                 WS_PROJ = 218 * MiB, WS_WADA = WS_PROJ, WS_U = WS_PROJ, WS_GB = WS_PROJ + 33 * MiB, WS_OB = WS_PROJ + 66 * MiB, WS_SZ = WS_PROJ + 132 * MiB, WS_SPROJ = WS_PROJ + 165 * MiB, WS_END = 482 * MiB;
constexpr int LDS_BYTES = 147456, LDS_MISC = LDS_BYTES - 64;
constexpr size_t WS_BAR = 4096;

#define LAS __attribute__((address_space(3)))
typedef unsigned short bf16;
typedef unsigned v4u __attribute__((ext_vector_type(4)));
typedef unsigned v2u __attribute__((ext_vector_type(2)));
typedef float f32x4 __attribute__((ext_vector_type(4)));
typedef float f32x2 __attribute__((ext_vector_type(2)));
typedef float f32x16 __attribute__((ext_vector_type(16)));
typedef short bf16x8 __attribute__((ext_vector_type(8)));
typedef __bf16 bf16x2n __attribute__((ext_vector_type(2)));
#define LDS_WAIT() asm volatile("s_waitcnt lgkmcnt(0)" ::: "memory")

__device__ __forceinline__ unsigned pk2(float lo, float hi) { f32x2 v = {lo, hi}; return __builtin_bit_cast(unsigned, __builtin_convertvector(v, bf16x2n)); }
__device__ __forceinline__ unsigned short f2bf(float f) { return (unsigned short)(pk2(f, 0.f) & 0xffffu); }
__device__ __forceinline__ float sigmoidf_(float x) { return 1.f / (1.f + __expf(-x)); }
__device__ __forceinline__ float siluf_(float x) { return x * sigmoidf_(x); }
__device__ __forceinline__ float wave_sum(float v) {
#pragma unroll
    for (int o = 1; o < 64; o <<= 1) v += __shfl_xor(v, o);
    return v;
}
__device__ __forceinline__ int mod_row(int r) { return r < MP ? (r >> 11) : 8 + ((r - MP) >> 2); }

#define XB_TMO      128
#define XB_XCNT(j)  (256  + 64 * (j))
#define XB_XSUB(j)  (1280 + 64 * (j))
#define XB_XGEN(j)  (2304 + 64 * (j))
#define XB_TOP      3328
#define XB_TOPGEN   3392
#define XCD_BAR_WORDS 3456
#define XB_SPIN_CAP (1u << 18)

__device__ __forceinline__ unsigned xb_ld(unsigned* p)              { return __hip_atomic_load(p, __ATOMIC_RELAXED, __HIP_MEMORY_SCOPE_AGENT); }
__device__ __forceinline__ unsigned xb_add(unsigned* p, unsigned v) { return __hip_atomic_fetch_add(p, v, __ATOMIC_RELAXED, __HIP_MEMORY_SCOPE_AGENT); }
__device__ __forceinline__ unsigned xb_xcc_id() { return (unsigned)__builtin_amdgcn_s_getreg((3 << 11) | 20) & 0xFu; }
#define XB_SPIN(cond, bar) do { unsigned _sp = 0; while (cond) { __builtin_amdgcn_s_sleep(1); \
    if ((++_sp & 255u) == 0u) { if (xb_ld(&(bar)[XB_TMO])) break; if (_sp > XB_SPIN_CAP) { atomicAdd(&(bar)[XB_TMO], 1u); break; } } } } while (0)

struct XcdBarrier {
    unsigned* bar; unsigned x;
    volatile LAS unsigned* st;
};

__device__ __forceinline__ XcdBarrier xcd_barrier_post(unsigned* bar, volatile LAS unsigned* st) {
    XcdBarrier b; b.bar = bar; b.x = xb_xcc_id(); b.st = st;
    if (threadIdx.x == 0) (void)xb_add(&bar[XB_XCNT(b.x)], 1u);
    return b;
}
__device__ __forceinline__ void xcd_barrier_complete(unsigned* bar, unsigned x, unsigned& nloc, unsigned& nx) {
    const unsigned G = gridDim.x * gridDim.y * gridDim.z;
    unsigned sum, cnt, mine, sp = 0u;
    for (;;) {
        sum = 0u; cnt = 0u; mine = 0u;
#pragma unroll
        for (unsigned j = 0; j < 16; ++j) { const unsigned c = xb_ld(&bar[XB_XCNT(j)]); sum += c; cnt += (c > 0u) ? 1u : 0u; mine = (j == x) ? c : mine; }
        if (sum == G) break;
        __builtin_amdgcn_s_sleep(1);
        if ((++sp & 255u) == 0u) { if (xb_ld(&bar[XB_TMO])) break; if (sp > XB_SPIN_CAP) { atomicAdd(&bar[XB_TMO], 1u); break; } }
    }
    nloc = mine > 0u ? mine : 1u; nx = cnt > 0u ? cnt : 1u;
}

__device__ __forceinline__ void xcd_barrier(const XcdBarrier& b) {
    asm volatile("s_waitcnt vmcnt(0)" ::: "memory");
    __syncthreads();
    if (threadIdx.x == 0) {
        unsigned* bar = b.bar;
        __builtin_amdgcn_s_waitcnt(0);
        unsigned nloc = b.st[0], nx = b.st[1];
        if (nloc == 0u) { xcd_barrier_complete(bar, b.x, nloc, nx); b.st[0] = nloc; b.st[1] = nx; }
        const unsigned old = xb_add(&bar[XB_XSUB(b.x)], 1u);
        const unsigned gen = old / nloc;
        if (old + 1u == (gen + 1u) * nloc) {
            __builtin_amdgcn_fence(__ATOMIC_RELEASE, "agent");
            asm volatile("s_waitcnt vmcnt(0)" ::: "memory");
            const unsigned og = xb_add(&bar[XB_TOP], 1u);
            const unsigned tg = og / nx;
            if (og + 1u == (tg + 1u) * nx) xb_add(&bar[XB_TOPGEN], 1u);
            else XB_SPIN(xb_ld(&bar[XB_TOPGEN]) == tg, bar);
            __builtin_amdgcn_fence(__ATOMIC_ACQUIRE, "agent");
            xb_add(&bar[XB_XGEN(b.x)], 1u);
            asm volatile("s_waitcnt vmcnt(0)" ::: "memory");
        } else {
            XB_SPIN(xb_ld(&bar[XB_XGEN(b.x)]) == gen, bar);
            __builtin_amdgcn_fence(__ATOMIC_ACQUIRE, "agent");
            asm volatile("s_waitcnt vmcnt(0)" ::: "memory");
        }
    }
    __syncthreads();
}


struct Params {
    const float* x_prompt; const float* x_sample; const float* state_conv; const float* state_hgrn;
    const float* c_prompt; const float* c_sample; const float* norm_g; const float* w_ada; const float* b_ada;
    const float* conv_w_in; const float* conv_w; const float* conv_w_out; const float* hgrn_w_in;
    const float* hgrn_lb; const float* hgrn_onorm_g; const float* hgrn_w_out; const float* final_norm_g;
    float* out; unsigned char* ws;
};


typedef const Params __attribute__((address_space(4))) * KPtr;
__device__ __forceinline__ KPtr kparams() { KPtr q = (KPtr)__builtin_amdgcn_kernarg_segment_ptr(); asm volatile("" : "+s"(q)); return q; }
#define KP(field) (kparams()->field)

struct EpiStoreF32 {
    static constexpr bool PERM = false, AFTER_DRAIN = false;
    float* C; int ldc; const float* bias;
    __device__ __forceinline__ void operator()(const f32x4 (&acc)[2][2][4][2], const pg8::Unit& u, int wr, int wc, int fr, int fq) const {
        const int row0 = u.pm * 256 + wr * 64 + fr, col0 = u.pn * 256 + wc * 32 + 4 * fq;
        f32x4 bv[2][2];
#pragma unroll
        for (int bj = 0; bj < 2; ++bj)
#pragma unroll
            for (int n = 0; n < 2; ++n) bv[bj][n] = bias ? *(const f32x4*)(bias + col0 + bj * 128 + n * 16) : (f32x4){0.f, 0.f, 0.f, 0.f};
#pragma unroll
        for (int ai = 0; ai < 2; ++ai)
#pragma unroll
            for (int m = 0; m < 4; ++m) { float* rowp = C + (size_t)(row0 + ai * 128 + m * 16) * ldc + col0;
#pragma unroll
                for (int bj = 0; bj < 2; ++bj)
#pragma unroll
                    for (int n = 0; n < 2; ++n) *(f32x4*)(rowp + bj * 128 + n * 16) = acc[ai][bj][m][n] + bv[bj][n]; }
    }
};
struct EpiResid {
    static constexpr bool PERM = false, AFTER_DRAIN = false;
    int layer; int dummy;
    __device__ __forceinline__ void operator()(const f32x4 (&acc)[2][2][4][2], const pg8::Unit& u, int wr, int wc, int fr, int fq) const {
        const KPtr p = kparams();
        float* X = p->out + O_Y;
        float* Xd = dummy ? (float*)(p->ws + WS_PROJ + 173 * MiB) : X;
        const float* xp = layer == 0 ? p->x_prompt : X; const float* xs = layer == 0 ? p->x_sample : X + (size_t)MP * D;
        const float* gate = (const float*)(p->ws + WS_MOD) + layer * 3072 + 2048;
        const int row0 = u.pm * 256 + wr * 64 + fr, col0 = u.pn * 256 + wc * 32 + 4 * fq;
#pragma unroll
        for (int ai = 0; ai < 2; ++ai)
#pragma unroll
            for (int m = 0; m < 4; ++m) {
                const int r = row0 + ai * 128 + m * 16;
                const float* xo = (r < MP) ? xp + (size_t)r * D : xs + (size_t)(r - MP) * D;
                const float* gp = gate + (size_t)mod_row(r) * MODLD;
                float* xn = Xd + (size_t)r * D;
#pragma unroll
                for (int bj = 0; bj < 2; ++bj)
#pragma unroll
                    for (int n = 0; n < 2; ++n) { const int c = col0 + bj * 128 + n * 16;
                        const f32x4 xv = *(const f32x4*)(xo + c), gv = *(const f32x4*)(gp + c);
                        *(f32x4*)(xn + c) = xv + gv * acc[ai][bj][m][n]; } }
    }
};


__device__ __forceinline__ f32x4 silu4(f32x4 z) { return (f32x4){siluf_(z.x), siluf_(z.y), siluf_(z.z), siluf_(z.w)}; }
struct EpiConv {
    static constexpr bool PERM = false, AFTER_DRAIN = false;
    int j;
    __device__ __forceinline__ void operator()(const f32x4 (&acc)[2][2][4][2], const pg8::Unit& u, int wr, int wc, int fr, int fq) const {
        const KPtr p = kparams();
        bf16* U = (bf16*)(p->ws + WS_U); bf16* GB = (bf16*)(p->ws + WS_GB);
        float* convp = p->out + O_CONVP + (size_t)j * 8 * 2 * 1024; float* convs = p->out + O_CONVS + (size_t)j * 128 * 2 * 1024;
        const int row0 = u.pm * 256 + wr * 64 + fr, e0 = u.pn * 64 + wc * 16 + 4 * fq;
#pragma unroll
        for (int ai = 0; ai < 2; ++ai)
#pragma unroll
            for (int m = 0; m < 4; ++m) {
                const int r = row0 + ai * 128 + m * 16;
                const f32x4 u4 = acc[ai][0][m][1] * acc[ai][1][m][0];
                const f32x4 g4 = acc[ai][0][m][0] * silu4(acc[ai][1][m][1]);
                v2u w; w.x = pk2(u4.x, u4.y); w.y = pk2(u4.z, u4.w); *(v2u*)(U + (size_t)r * D + e0) = w;
                w.x = pk2(g4.x, g4.y); w.y = pk2(g4.z, g4.w); *(v2u*)(GB + (size_t)r * D + e0) = w;
                if (r < MP) { const int t = r & 2047; if (t >= 2046) *(f32x4*)(convp + ((size_t)(r >> 11) * 2 + (t - 2046)) * 1024 + e0) = u4; }
                else { const int t = (r - MP) & 3; if (t >= 2) *(f32x4*)(convs + ((size_t)((r - MP) >> 2) * 2 + (t - 2)) * 1024 + e0) = u4; }
            }
    }
};


template <int CTRL> __device__ __forceinline__ float dppf(float x) { return __builtin_bit_cast(float, __builtin_amdgcn_update_dpp(0, __builtin_bit_cast(int, x), CTRL, 0xf, 0xf, false)); }
__device__ __forceinline__ float scan16(float x) {
    x += dppf<0x111>(x); x += dppf<0x112>(x); x += dppf<0x114>(x); x += dppf<0x118>(x); return x;
}
__device__ __forceinline__ void quad_transpose(float (&x)[4], int lane) {
    const bool p0 = (lane & 1) != 0, p1 = (lane & 2) != 0;
#pragma unroll
    for (int c = 0; c < 4; c += 2) { const float send = p0 ? x[c] : x[c + 1]; const float recv = dppf<0xB1>(send); if (p0) x[c] = recv; else x[c + 1] = recv; }
#pragma unroll
    for (int c = 0; c < 2; ++c) { const float send = p1 ? x[c] : x[c + 2]; const float recv = dppf<0x4E>(send); if (p1) x[c] = recv; else x[c + 2] = recv; }
}
__device__ __forceinline__ float ex2(float x) { return __builtin_amdgcn_exp2f(x); }
__device__ __forceinline__ float sigm2(float x) { return __builtin_amdgcn_rcpf(1.f + ex2(-1.4426950408889634f * x)); }

struct EpiHgrn {
    static constexpr bool PERM = false, AFTER_DRAIN = false;
    int layer;
    __device__ __forceinline__ void operator()(const f32x4 (&acc)[2][2][4][2], const pg8::Unit& u, int wr, int wc, int fr, int fq) const {
        unsigned char* ws = kparams()->ws;
        bf16* FRQ = (bf16*)(ws + WS_FRQ); bf16* FRK = (bf16*)(ws + WS_FRK); bf16* FRKT = (bf16*)(ws + WS_FRKT); bf16* FRV = (bf16*)(ws + WS_FRV); bf16* SZ = (bf16*)(ws + WS_SZ);
        float* DEC = (float*)(ws + WS_DEC); float* SPROJ = (float*)(ws + WS_SPROJ); const float* lbs = (const float*)(ws + WS_LBS) + layer * 1024;
        const int h = u.pn & 7; const bool qf = u.pn < 8;
        const int lr0 = wr * 64 + fr, lane = fr + 16 * fq;
        const int cin = 32 * wc + 4 * fq;
        if (u.pm >= 64) {
            const int row0 = (u.pm - 64) * 256 + lr0;
#pragma unroll
            for (int ai = 0; ai < 2; ++ai)
#pragma unroll
                for (int m = 0; m < 4; ++m) { const int row = row0 + ai * 128 + m * 16; float* rp = SPROJ + (size_t)row * NPROJ + u.pn * 256 + cin;
#pragma unroll
                    for (int n = 0; n < 2; ++n) {
                        *(f32x4*)(rp + 16 * n) = acc[ai][0][m][n];
                        if (qf) *(f32x4*)(rp + 128 + 16 * n) = acc[ai][1][m][n];
                        else { const f32x4 z = acc[ai][1][m][n]; v2u w; w.x = pk2(siluf_(z.x), siluf_(z.y)); w.y = pk2(siluf_(z.z), siluf_(z.w));
                            *(v2u*)(SZ + (size_t)(MP + row) * D + h * 128 + cin + 16 * n) = w; } } }
            return;
        }
        const int b = u.pm >> 3, cbase = (u.pm & 7) * 8;
        const int hfs = (fr >> 2) & 1, j0s = 4 * (fr >> 3);
        if (!qf) {
#pragma unroll
            for (int ai = 0; ai < 2; ++ai)
#pragma unroll
                for (int m = 0; m < 4; ++m) {
                    const int r = u.pm * 256 + lr0 + ai * 128 + m * 16, c = cbase + 4 * ai + 2 * wr + (m >> 1);
                    const size_t base = ((size_t)((b * 8 + h) * 64 + c)) * 4096;
#pragma unroll
                    for (int n = 0; n < 2; ++n) {
                        const f32x4 z = acc[ai][1][m][n]; v2u w; w.x = pk2(siluf_(z.x), siluf_(z.y)); w.y = pk2(siluf_(z.z), siluf_(z.w));
                        *(v2u*)(SZ + (size_t)r * D + h * 128 + cin + 16 * n) = w;
                        float x[4] = {acc[ai][0][m][n].x, acc[ai][0][m][n].y, acc[ai][0][m][n].z, acc[ai][0][m][n].w};
                        quad_transpose(x, lane);
                        w.x = pk2(x[0], x[1]); w.y = pk2(x[2], x[3]);
                        *(v2u*)(FRV + base + ((size_t)((wc * 2 + (m & 1)) * 64 + 16 * n + 4 * fq + (fr & 3) + 32 * hfs)) * 8 + j0s) = w;
                    }
                }
            return;
        }
        f32x4 lb4[2];
#pragma unroll
        for (int n = 0; n < 2; ++n) lb4[n] = *(const f32x4*)(lbs + h * 128 + cin + 16 * n);
#pragma unroll
        for (int ai = 0; ai < 2; ++ai)
#pragma unroll
            for (int mp = 0; mp < 2; ++mp) {
                const int c = cbase + 4 * ai + 2 * wr + mp;
                const size_t base = ((size_t)((b * 8 + h) * 64 + c)) * 4096;
#pragma unroll
                for (int n = 0; n < 2; ++n) {
                    float Gs[2][4], kk[2][4];
#pragma unroll
                    for (int mm = 0; mm < 2; ++mm)
#pragma unroll
                        for (int j = 0; j < 4; ++j) { const float lb = lb4[n][j]; const float f = lb + (1.f - lb) * sigm2(acc[ai][1][2 * mp + mm][n][j]);
                            kk[mm][j] = 1.f - f; Gs[mm][j] = scan16(__builtin_amdgcn_logf(f)); }
#pragma unroll
                    for (int j = 0; j < 4; ++j) Gs[1][j] += __shfl(Gs[0][j], 15, 16);
#pragma unroll
                    for (int mm = 0; mm < 2; ++mm) {
                        const int t = 16 * mm + fr;
                        float qt[4], kt[4];
#pragma unroll
                        for (int j = 0; j < 4; ++j) { const float q = acc[ai][0][2 * mp + mm][n][j]; qt[j] = q * sigm2(q) * ex2(Gs[mm][j]); kt[j] = kk[mm][j] * ex2(-Gs[mm][j]); }
                        const size_t o = base + ((size_t)((wc * 2 + n) * 64 + t + 32 * (fq & 1))) * 8 + 4 * (fq >> 1);
                        v2u w; w.x = pk2(qt[0], qt[1]); w.y = pk2(qt[2], qt[3]); *(v2u*)(FRQ + o) = w;
                        w.x = pk2(kt[0], kt[1]); w.y = pk2(kt[2], kt[3]); *(v2u*)(FRK + o) = w;
                        quad_transpose(kt, lane);
                        w.x = pk2(kt[0], kt[1]); w.y = pk2(kt[2], kt[3]);
                        *(v2u*)(FRKT + base + ((size_t)((wc * 2 + mm) * 64 + 16 * n + 4 * fq + (fr & 3) + 32 * hfs)) * 8 + j0s) = w;
                    }
                    if (fr == 15) *(f32x4*)(DEC + (size_t)(b * 64 + c) * 1024 + h * 128 + cin + 16 * n) = (f32x4){ex2(Gs[1][0]), ex2(Gs[1][1]), ex2(Gs[1][2]), ex2(Gs[1][3])};
                }
            }
    }
};

__device__ __forceinline__ int src_col(int mode, int np) {
    if (mode == 0) return np;
    if (mode == 1) { const int pn = np >> 8, cl = np & 255, bj = cl >> 7, wc = (cl >> 5) & 3, n = (cl >> 4) & 1, rest = cl & 15;
        return (2 * bj + n) * 1024 + 64 * pn + 16 * wc + rest; }
    const int pn = np >> 8, bj = (np >> 7) & 1, idx = np & 127;
    return pn < 8 ? bj * 1024 + 128 * pn + idx : 2048 + bj * 1024 + 128 * (pn - 8) + idx;
}
__device__ __forceinline__ void transpose_item(const float* W, int N, bf16* WT, int row_off, int mode, LAS float* scr, int item, int lane) {
    const int nblk = N / 32, kb = item / nblk, nb = item % nblk, k0 = 64 * kb, n0 = 32 * nb;
    const int sc = src_col(mode, n0 + (lane & 31));
#pragma unroll 8
    for (int i = 0; i < 32; ++i) { const int kk = 2 * i + (lane >> 5); scr[kk * 33 + (lane & 31)] = W[(size_t)(k0 + kk) * N + sc]; }
    LDS_WAIT(); asm volatile("" ::: "memory");
    const int c = lane & 7;
#pragma unroll
    for (int j = 0; j < 4; ++j) { const int n = (lane >> 3) + 8 * j; const LAS float* s = scr + (8 * c) * 33 + n;
        v4u o; o.x = pk2(s[0 * 33], s[1 * 33]); o.y = pk2(s[2 * 33], s[3 * 33]); o.z = pk2(s[4 * 33], s[5 * 33]); o.w = pk2(s[6 * 33], s[7 * 33]);
        *(v4u*)(WT + (size_t)(row_off + n0 + n) * 1024 + k0 + 8 * c) = o; }
    LDS_WAIT(); asm volatile("" ::: "memory");
}

__device__ __forceinline__ void phase_prologue(LAS unsigned char* lds, int G) {
    const KPtr p = kparams();
    const int tid = opaque_tid(), lane = tid & 63, wave = tid >> 6;
    const int gw = opaque_bid() * NWAVES + wave, NGW = G * NWAVES;
    LAS float* scr = (LAS float*)(lds + wave * 16384);
    unsigned char* ws = p->ws;
    constexpr int I_IN = 16 * 128, I_OUT = 16 * 32, I_ADA = 16 * 96;
    constexpr int NITEMS = 4 * I_IN + 4 * I_OUT + 4 * I_ADA;
    for (int it = gw; it < NITEMS; it += NGW) {
        int r = it;
        if (r < 4 * I_ADA) { const int l = r / I_ADA; transpose_item(p->w_ada + (size_t)l * 1024 * 3072, 3072, (bf16*)(ws + WS_WADA), l * 3072, 0, scr, r % I_ADA, lane); continue; } r -= 4 * I_ADA;
        if (r < 2 * I_IN) { const int j = r / I_IN; transpose_item(p->conv_w_in + (size_t)j * 1024 * 4096, 4096, (bf16*)(ws + WS_WCIN) + (size_t)j * 4096 * 1024, 0, 1, scr, r % I_IN, lane); continue; } r -= 2 * I_IN;
        if (r < 2 * I_IN) { const int j = r / I_IN; transpose_item(p->hgrn_w_in + (size_t)j * 1024 * 4096, 4096, (bf16*)(ws + WS_WHIN) + (size_t)j * 4096 * 1024, 0, 2, scr, r % I_IN, lane); continue; } r -= 2 * I_IN;
        if (r < 2 * I_OUT) { const int j = r / I_OUT; transpose_item(p->conv_w_out + (size_t)j * 1024 * 1024, 1024, (bf16*)(ws + WS_WCOUT) + (size_t)j * 1024 * 1024, 0, 0, scr, r % I_OUT, lane); continue; } r -= 2 * I_OUT;
        { const int j = r / I_OUT; transpose_item(p->hgrn_w_out + (size_t)j * 1024 * 1024, 1024, (bf16*)(ws + WS_WHOUT) + (size_t)j * 1024 * 1024, 0, 0, scr, r % I_OUT, lane); }
    }
    const int gt = opaque_bid() * NTHREADS + tid, NGT = G * NTHREADS;
    bf16* act = (bf16*)(ws + WS_ACT);
    for (int i = gt; i < 256 * 1024; i += NGT) { const int r = i >> 10, d = i & 1023;
        float v = 0.f; if (r < 8) v = siluf_(p->c_prompt[r * 1024 + d]); else if (r < 136) v = siluf_(p->c_sample[(r - 8) * 1024 + d]);
        act[i] = f2bf(v); }
    float* lbs = (float*)(ws + WS_LBS);
    for (int e = gt; e < 1024; e += NGT) {
        const float a0 = p->hgrn_lb[e], a1 = p->hgrn_lb[1024 + e], a2 = p->hgrn_lb[2048 + e], a3 = p->hgrn_lb[3072 + e];
        const float mx = fmaxf(fmaxf(a0, a1), fmaxf(a2, a3));
        const float e0 = __expf(a0 - mx), e1 = __expf(a1 - mx), e2 = __expf(a2 - mx), e3 = __expf(a3 - mx), inv = 1.f / (e0 + e1 + e2 + e3);
        lbs[e] = 0.f; lbs[1024 + e] = e1 * inv; lbs[2048 + e] = (e1 + e2) * inv; lbs[3072 + e] = (e1 + e2 + e3) * inv; }
}

__device__ __forceinline__ void phase_norm(int layer, int G) {
    const KPtr p = kparams();
    const int tid = opaque_tid(), lane = tid & 63, wave = tid >> 6;
    const int gw = opaque_bid() * NWAVES + wave, NGW = G * NWAVES;
    const float* mod = (const float*)(p->ws + WS_MOD) + layer * 3072;
    const float* X = p->out + O_Y;
    bf16* HB = (bf16*)(p->ws + WS_HB);
    const f32x4* g4 = (const f32x4*)(p->norm_g + layer * D) + lane;
    for (int r = gw; r < M; r += NGW) {
        const float* xrow = (layer == 0) ? (r < MP ? p->x_prompt + (size_t)r * D : p->x_sample + (size_t)(r - MP) * D) : X + (size_t)r * D;
        const f32x4* xr = (const f32x4*)xrow + lane;
        f32x4 v[4]; float s = 0.f;
#pragma unroll
        for (int j = 0; j < 4; ++j) { v[j] = xr[64 * j]; s += (v[j].x * v[j].x + v[j].y * v[j].y) + (v[j].z * v[j].z + v[j].w * v[j].w); }
        const float rstd = 1.f / sqrtf(wave_sum(s) * (1.f / D) + EPS);
        const float* mr = mod + (size_t)mod_row(r) * MODLD;
        const f32x4* sh4 = (const f32x4*)mr + lane; const f32x4* sc4 = (const f32x4*)(mr + 1024) + lane;
        v2u* o8 = (v2u*)(HB + (size_t)r * D) + lane;
#pragma unroll
        for (int j = 0; j < 4; ++j) { const f32x4 g = g4[64 * j], sh = sh4[64 * j], sc = sc4[64 * j];
            const f32x4 h = v[j] * rstd * g * (sc + 1.f) + sh;
            v2u w; w.x = pk2(h.x, h.y); w.y = pk2(h.z, h.w); o8[64 * j] = w; }
    }
}

__device__ __forceinline__ void phase_final(int G) {
    const KPtr p = kparams();
    const int tid = opaque_tid(), lane = tid & 63, wave = tid >> 6;
    const int gw = opaque_bid() * NWAVES + wave, NGW = G * NWAVES;
    float* X = p->out + O_Y;
    const f32x4* g4 = (const f32x4*)p->final_norm_g + lane;
    for (int r = gw; r < M; r += NGW) {
        f32x4* xr = (f32x4*)(X + (size_t)r * D) + lane;
        f32x4 v[4]; float s = 0.f;
#pragma unroll
        for (int j = 0; j < 4; ++j) { v[j] = xr[64 * j]; s += (v[j].x * v[j].x + v[j].y * v[j].y) + (v[j].z * v[j].z + v[j].w * v[j].w); }
        const float rstd = 1.f / sqrtf(wave_sum(s) * (1.f / D) + EPS);
#pragma unroll
        for (int j = 0; j < 4; ++j) xr[64 * j] = v[j] * rstd * g4[64 * j];
    }
}

__device__ __forceinline__ void bf8_to_f(const v4u w, float (&f)[8]) {
#pragma unroll
    for (int i = 0; i < 4; ++i) { f[2 * i] = __builtin_bit_cast(float, w[i] << 16); f[2 * i + 1] = __builtin_bit_cast(float, w[i] & 0xffff0000u); }
}
__device__ __forceinline__ void phase_conv_y(int j, int G) {
    const KPtr p = kparams();
    const int tid = opaque_tid();
    const bf16* U = (const bf16*)(p->ws + WS_U); const bf16* GB = (const bf16*)(p->ws + WS_GB);
    bf16* YB = (bf16*)(p->ws + WS_HB);
    const int e = (tid & 127) * 8;
    float w0[8], w1[8], w2[8];
    { const float* cw = p->conv_w + (size_t)j * 3 * 1024 + e;
#pragma unroll
      for (int i = 0; i < 8; ++i) { w0[i] = cw[i]; w1[i] = cw[1024 + i]; w2[i] = cw[2048 + i]; } }
    const float* st = p->state_conv + (size_t)j * 128 * 2 * 1024;
    for (int rg = opaque_bid(); rg < M / 4; rg += G) {
        const int r = rg * 4 + (tid >> 7);
        const bool samp = r >= MP; const int t = samp ? ((r - MP) & 3) : (r & 2047); const int seq = samp ? ((r - MP) >> 2) : (r >> 11);
        float g[8], u0[8], u1[8], u2[8];
        bf8_to_f(*(const v4u*)(GB + (size_t)r * D + e), g);
        bf8_to_f(*(const v4u*)(U + (size_t)r * D + e), u0);
        if (t >= 1) bf8_to_f(*(const v4u*)(U + (size_t)(r - 1) * D + e), u1);
        else if (samp) {
#pragma unroll
            for (int i = 0; i < 8; ++i) u1[i] = st[((size_t)seq * 2 + 1) * 1024 + e + i]; }
        else {
#pragma unroll
            for (int i = 0; i < 8; ++i) u1[i] = 0.f; }
        if (t >= 2) bf8_to_f(*(const v4u*)(U + (size_t)(r - 2) * D + e), u2);
        else if (samp) {
#pragma unroll
            for (int i = 0; i < 8; ++i) u2[i] = st[((size_t)seq * 2 + t) * 1024 + e + i]; }
        else {
#pragma unroll
            for (int i = 0; i < 8; ++i) u2[i] = 0.f; }
        v4u o;
#pragma unroll
        for (int i = 0; i < 4; ++i) o[i] = pk2(g[2 * i] * (w0[2 * i] * u2[2 * i] + w1[2 * i] * u1[2 * i] + w2[2 * i] * u0[2 * i]),
                                               g[2 * i + 1] * (w0[2 * i + 1] * u2[2 * i + 1] + w1[2 * i + 1] * u1[2 * i + 1] + w2[2 * i + 1] * u0[2 * i + 1]));
        *(v4u*)(YB + (size_t)r * D + e) = o;
    }
}

#define MFMA32(a, b, c) __builtin_amdgcn_mfma_f32_32x32x16_bf16((a), (b), (c), 0, 0, 0)
__device__ __forceinline__ bf16x8 pack8(const f32x16& x, int s) {
    v4u w; w.x = pk2(x[8 * s + 0], x[8 * s + 1]); w.y = pk2(x[8 * s + 2], x[8 * s + 3]); w.z = pk2(x[8 * s + 4], x[8 * s + 5]); w.w = pk2(x[8 * s + 6], x[8 * s + 7]);
    return __builtin_bit_cast(bf16x8, w);
}
constexpr int REC_SLOT = 33280, REC_KF = 8192, REC_KT = 16384, REC_VF = 24576, REC_D = 32768;
__device__ __forceinline__ void rec_issue(const unsigned char* gq, const unsigned char* gk, const unsigned char* gkt, const unsigned char* gv, const unsigned char* gd,
                                          LAS unsigned char* slot, int lw, int lane) {
    const unsigned char* src = lw == 0 ? gq : (lw == 1 ? gk : (lw == 2 ? gkt : gv));
    LAS unsigned char* dst = slot + lw * 8192;
#pragma unroll
    for (int f = 0; f < 8; ++f) __builtin_amdgcn_global_load_lds((const unsigned*)(src + f * 1024 + lane * 16), (LAS unsigned*)(dst + f * 1024), 16, 0, 0);
    if (lw == 0 && lane < 32) __builtin_amdgcn_global_load_lds((const unsigned*)(gd + lane * 16), (LAS unsigned*)(slot + REC_D), 16, 0, 0);
}
__device__ __forceinline__ void hgrn_prompt_block(int j, int item, LAS unsigned char* lds) {
    const KPtr p = kparams();
    const int tid = opaque_tid(), lane = tid & 63, wave = __builtin_amdgcn_readfirstlane(tid >> 6);
    const int b = item >> 3, h = item & 7;
    const size_t bh = (size_t)(b * 8 + h) * 64;
    if (wave >= 4) {
        const int lw = wave - 4;
        const unsigned char* gq = (const unsigned char*)(p->ws + WS_FRQ) + bh * 8192; const unsigned char* gk = (const unsigned char*)(p->ws + WS_FRK) + bh * 8192;
        const unsigned char* gkt = (const unsigned char*)(p->ws + WS_FRKT) + bh * 8192; const unsigned char* gv = (const unsigned char*)(p->ws + WS_FRV) + bh * 8192;
        const unsigned char* gd = (const unsigned char*)(p->ws + WS_DEC) + ((size_t)b * 64 * 1024 + h * 128) * 4;
#pragma unroll
        for (int c = 0; c < 3; ++c) rec_issue(gq + c * 8192, gk + c * 8192, gkt + c * 8192, gv + c * 8192, gd + c * 4096, lds + c * REC_SLOT, lw, lane);
        for (int c = 0; c < 64; ++c) {
            if (c < 61) { if (lw == 0) asm volatile("s_waitcnt vmcnt(18)" ::: "memory"); else asm volatile("s_waitcnt vmcnt(16)" ::: "memory"); }
            else asm volatile("s_waitcnt vmcnt(0)" ::: "memory");
            __builtin_amdgcn_s_barrier();
            asm volatile("" ::: "memory");
            if (c + 3 < 64) { const int cn = c + 3; rec_issue(gq + cn * 8192, gk + cn * 8192, gkt + cn * 8192, gv + cn * 8192, gd + cn * 4096, lds + (cn & 3) * REC_SLOT, lw, lane); }
        }
    } else {
        const int vs = wave, hf = lane >> 5, l31 = lane & 31;
        float* O = (float*)(p->ws + WS_OB);
        f32x16 S[4];
#pragma unroll
        for (int kt = 0; kt < 4; ++kt)
#pragma unroll
            for (int i = 0; i < 16; ++i) S[kt][i] = 0.f;
        for (int c = 0; c < 64; ++c) {
            __builtin_amdgcn_s_barrier();
            asm volatile("" ::: "memory");
            const LAS unsigned char* slot = lds + (c & 3) * REC_SLOT;
            const LAS bf16x8* qp = (const LAS bf16x8*)slot + lane; const LAS bf16x8* kp = (const LAS bf16x8*)(slot + REC_KF) + lane;
            const LAS bf16x8* ktp = (const LAS bf16x8*)(slot + REC_KT) + lane; const LAS bf16x8* vp = (const LAS bf16x8*)(slot + REC_VF) + vs * 128 + lane;
            const LAS float* dp = (const LAS float*)(slot + REC_D) + 4 * hf;
            bf16x8 QF[8], KF[8], VF[2];
#pragma unroll
            for (int f = 0; f < 8; ++f) { QF[f] = qp[f * 64]; KF[f] = kp[f * 64]; }
            VF[0] = vp[0]; VF[1] = vp[64];
            f32x16 at;
#pragma unroll
            for (int i = 0; i < 16; ++i) at[i] = 0.f;
#pragma unroll
            for (int f = 0; f < 8; ++f) at = MFMA32(KF[f], QF[f], at);
#pragma unroll
            for (int i = 0; i < 16; ++i) { const int s = (i & 3) + 8 * (i >> 2) + 4 * hf; at[i] = (s <= l31) ? at[i] : 0.f; }
            const bf16x8 atp0 = pack8(at, 0), atp1 = pack8(at, 1);
            bf16x8 KT[8]; f32x4 dd[4][4];
#pragma unroll
            for (int f = 0; f < 8; ++f) KT[f] = ktp[f * 64];
#pragma unroll
            for (int kt = 0; kt < 2; ++kt)
#pragma unroll
                for (int g = 0; g < 4; ++g) dd[kt][g] = *(const LAS f32x4*)(dp + 32 * kt + 8 * g);
            __builtin_amdgcn_sched_barrier(0);
            f32x16 o;
#pragma unroll
            for (int i = 0; i < 16; ++i) o[i] = 0.f;
#pragma unroll
            for (int kt = 0; kt < 4; ++kt) { o = MFMA32(pack8(S[kt], 0), QF[kt * 2], o); o = MFMA32(pack8(S[kt], 1), QF[kt * 2 + 1], o); }
            o = MFMA32(VF[0], atp0, o); o = MFMA32(VF[1], atp1, o);
            float* orow = O + (size_t)(b * 2048 + c * 32 + l31) * D + 128 * h + 32 * vs + 4 * hf;
#pragma unroll
            for (int g = 0; g < 4; ++g) *(f32x4*)(orow + 8 * g) = (f32x4){o[4 * g], o[4 * g + 1], o[4 * g + 2], o[4 * g + 3]};
#pragma unroll
            for (int kt = 0; kt < 4; ++kt) {
                if (kt == 0) {
#pragma unroll
                    for (int k2 = 2; k2 < 4; ++k2)
#pragma unroll
                        for (int g = 0; g < 4; ++g) dd[k2][g] = *(const LAS f32x4*)(dp + 32 * k2 + 8 * g);
                    __builtin_amdgcn_sched_barrier(0);
                }
                S[kt] = MFMA32(KT[kt * 2], VF[0], S[kt]); S[kt] = MFMA32(KT[kt * 2 + 1], VF[1], S[kt]);
#pragma unroll
                for (int g = 0; g < 4; ++g) { const f32x4 d = dd[kt][g];
                    S[kt][4 * g] *= d.x; S[kt][4 * g + 1] *= d.y; S[kt][4 * g + 2] *= d.z; S[kt][4 * g + 3] *= d.w; }
            }
            asm volatile("s_waitcnt lgkmcnt(0)" ::: "memory");
        }
        float* so = p->out + O_HGP + ((size_t)((j * 8 + b) * 8 + h)) * 16384 + 32 * vs + l31;
#pragma unroll
        for (int kt = 0; kt < 4; ++kt)
#pragma unroll
            for (int i = 0; i < 16; ++i) so[(size_t)(32 * kt + (i & 3) + 8 * (i >> 2) + 4 * hf) * 128] = S[kt][i];
    }
    __syncthreads();
}

__device__ __forceinline__ void hgrn_sample_wave(int layer, int j, int item, LAS float* L, int lane) {
    const KPtr p = kparams();
    const int s = item >> 3, h = item & 7;
    const float* PROJ = (const float*)(p->ws + WS_SPROJ);
    float* OB = (float*)(p->ws + WS_OB);
    const float* lbs = (const float*)(p->ws + WS_LBS) + layer * 1024;
    LAS float* sc = L; LAS float* vv = L + 128 * 12;
    const size_t r0 = (size_t)(4 * s);
    const int vg = lane & 31, kh = lane >> 5;
    const float* S0 = p->state_hgrn + ((size_t)((j * 128 + s) * 8 + h)) * 16384 + (size_t)(kh * 64) * 128 + 4 * vg;
    float* S1 = p->out + O_HGS + ((size_t)((j * 128 + s) * 8 + h)) * 16384 + (size_t)(kh * 64) * 128 + 4 * vg;
    float A[4][4];
#pragma unroll
    for (int t = 0; t < 4; ++t)
#pragma unroll
        for (int u = 0; u < 4; ++u) A[t][u] = 0.f;
#pragma unroll
    for (int kk2 = 0; kk2 < 2; ++kk2) {
        const int k = lane + 64 * kk2; const float lb = lbs[h * 128 + k];
        float sq[4], kk[4], Gt[4]; float Gc = 0.f;
#pragma unroll
        for (int t = 0; t < 4; ++t) { const float* pr = PROJ + (r0 + t) * NPROJ + 256 * h + k;
            const float q = pr[0], fp = pr[128]; const float f = lb + (1.f - lb) * sigmoidf_(fp);
            Gc += __logf(f); Gt[t] = Gc; sq[t] = siluf_(q); kk[t] = 1.f - f;
            vv[t * 128 + k] = pr[2048]; }
#pragma unroll
        for (int t = 0; t < 4; ++t) { sc[k * 12 + t] = sq[t] * __expf(Gt[t]); sc[k * 12 + 4 + t] = kk[t] * __expf(Gt[3] - Gt[t]); }
        sc[k * 12 + 8] = __expf(Gt[3]);
#pragma unroll
        for (int t = 0; t < 4; ++t)
#pragma unroll
            for (int u = 0; u <= t; ++u) A[t][u] += sq[t] * kk[u] * __expf(Gt[t] - Gt[u]);
    }
#pragma unroll
    for (int t = 0; t < 4; ++t)
#pragma unroll
        for (int u = 0; u <= t; ++u) A[t][u] = wave_sum(A[t][u]);
    LDS_WAIT(); asm volatile("" ::: "memory");
    f32x4 v4[4], po[4];
#pragma unroll
    for (int t = 0; t < 4; ++t) { v4[t] = *(const LAS f32x4*)(vv + t * 128 + 4 * vg); po[t] = (f32x4){0.f, 0.f, 0.f, 0.f}; }
#pragma unroll 1
    for (int i0 = 0; i0 < 64; i0 += 8) {
        f32x4 s0[8];
#pragma unroll
        for (int i = 0; i < 8; ++i) s0[i] = *(const f32x4*)(S0 + (size_t)(i0 + i) * 128);
#pragma unroll
        for (int i = 0; i < 8; ++i) {
            const LAS f32x4* c4 = (const LAS f32x4*)(sc + (kh * 64 + i0 + i) * 12);
            const f32x4 qe = c4[0], kd = c4[1]; const float eg = c4[2].x;
            f32x4 sn = s0[i] * eg;
            sn += v4[0] * kd.x; sn += v4[1] * kd.y; sn += v4[2] * kd.z; sn += v4[3] * kd.w;
            po[0] += s0[i] * qe.x; po[1] += s0[i] * qe.y; po[2] += s0[i] * qe.z; po[3] += s0[i] * qe.w;
            *(f32x4*)(S1 + (size_t)(i0 + i) * 128) = sn;
        }
    }
#pragma unroll
    for (int t = 0; t < 4; ++t) { po[t].x += __shfl_xor(po[t].x, 32); po[t].y += __shfl_xor(po[t].y, 32); po[t].z += __shfl_xor(po[t].z, 32); po[t].w += __shfl_xor(po[t].w, 32); }
    if (kh == 0) {
#pragma unroll
        for (int t = 0; t < 4; ++t) { f32x4 o = po[t];
#pragma unroll
            for (int u = 0; u <= t; ++u) o += v4[u] * A[t][u];
            *(f32x4*)(OB + (MP + r0 + t) * D + 128 * h + 4 * vg) = o; }
    }
    LDS_WAIT(); asm volatile("" ::: "memory");
}

__device__ __forceinline__ void phase_hgrn_rec(int layer, int j, LAS unsigned char* lds, int G) {
    const int bid = opaque_bid();
    if (bid < 64) hgrn_prompt_block(j, bid, lds);
    else {
        const int tid = opaque_tid(), lane = tid & 63, wave = __builtin_amdgcn_readfirstlane(tid >> 6);
        const int nb = G - 64;
        for (int item = wave * nb + (bid - 64); item < 1024; item += 8 * nb) hgrn_sample_wave(layer, j, item, (LAS float*)(lds + wave * 8192), lane);
    }
}

__device__ __forceinline__ void phase_hgrn_y(int j, int G) {
    const KPtr p = kparams();
    const int tid = opaque_tid(), lane = tid & 63, wave = tid >> 6;
    const int gw = opaque_bid() * NWAVES + wave, NGW = G * NWAVES;
    const float* OB = (const float*)(p->ws + WS_OB); const bf16* SZ = (const bf16*)(p->ws + WS_SZ);
    bf16* YB = (bf16*)(p->ws + WS_HB);
    const float* og = p->hgrn_onorm_g + (size_t)j * 1024;
    for (int r = gw; r < M; r += NGW) {
#pragma unroll
        for (int jj = 0; jj < 4; ++jj) {
            const int e = 4 * lane + 256 * jj;
            const f32x4 o = *(const f32x4*)(OB + (size_t)r * D + e), g = *(const f32x4*)(og + e);
            const v2u zz = *(const v2u*)(SZ + (size_t)r * D + e);
            const float z0 = __builtin_bit_cast(float, zz.x << 16), z1 = __builtin_bit_cast(float, zz.x & 0xffff0000u), z2 = __builtin_bit_cast(float, zz.y << 16), z3 = __builtin_bit_cast(float, zz.y & 0xffff0000u);
            float ss = (o.x * o.x + o.y * o.y) + (o.z * o.z + o.w * o.w);
#pragma unroll
            for (int m = 1; m < 32; m <<= 1) ss += __shfl_xor(ss, m);
            const float rs = 1.f / sqrtf(ss * (1.f / 128.f) + EPS);
            v2u w; w.x = pk2(o.x * rs * g.x * z0, o.y * rs * g.y * z1); w.y = pk2(o.z * rs * g.z * z2, o.w * rs * g.w * z3);
            *(v2u*)(YB + (size_t)r * D + e) = w;
        }
    }
}


__device__ __forceinline__ void mini_load(bf16x8 (&a)[4], bf16x8 (&b)[4], const bf16* pa, const bf16* pb, int kc) {
#pragma unroll
    for (int q = 0; q < 4; ++q) { a[q] = *(const bf16x8*)(pa + kc * 64 + 8 * q); b[q] = *(const bf16x8*)(pb + kc * 64 + 8 * q); }
}
__device__ __forceinline__ f32x16 mini_tile(const bf16* WT, int wrow, const bf16* ACT, int arow, int hf) {
    const bf16* pa = WT + (size_t)wrow * 1024 + 32 * hf; const bf16* pb = ACT + (size_t)arow * 1024 + 32 * hf;
    f32x16 acc;
#pragma unroll
    for (int i = 0; i < 16; ++i) acc[i] = 0.f;
    bf16x8 a[4][4], b[4][4];
    mini_load(a[0], b[0], pa, pb, 0); mini_load(a[1], b[1], pa, pb, 1); mini_load(a[2], b[2], pa, pb, 2);
#pragma unroll
    for (int kc = 0; kc < 16; ++kc) {
        if (kc + 3 < 16) mini_load(a[(kc + 3) & 3], b[(kc + 3) & 3], pa, pb, kc + 3);
#pragma unroll
        for (int q = 0; q < 4; ++q) acc = MFMA32(a[kc & 3][q], b[kc & 3][q], acc);
    }
    return acc;
}
__device__ __forceinline__ void mini_conv_in(int j, int G) {
    const KPtr p = kparams();
    const int tid = opaque_tid(), lane = tid & 63, wave = tid >> 6, hf = lane >> 5, l31 = lane & 31;
    const bf16* WT = (const bf16*)(p->ws + WS_WCIN) + (size_t)j * 4096 * 1024; const bf16* HB = (const bf16*)(p->ws + WS_HB);
    bf16* U = (bf16*)(p->ws + WS_U); bf16* GB = (bf16*)(p->ws + WS_GB);
    float* convs = p->out + O_CONVS + (size_t)j * 128 * 2 * 1024;
    for (int bt = opaque_bid(); bt < 256; bt += G) {
        const int tt = 4 * (bt & 3) + (wave & 3), et = 2 * (bt >> 2) + (wave >> 2);
        const int qty = l31 >> 3, e = 8 * et + (l31 & 7);
        const int wrow = 256 * (e >> 6) + 128 * (qty >> 1) + 32 * ((e >> 4) & 3) + 16 * (qty & 1) + (e & 15);
        const int rs = 32 * tt + l31;
        const f32x16 a = mini_tile(WT, wrow, HB, MP + rs, hf);
        const int e0 = 8 * et + 4 * hf;
        const f32x4 u4 = (f32x4){a[4] * a[8], a[5] * a[9], a[6] * a[10], a[7] * a[11]};
        const f32x4 g4 = (f32x4){a[0] * siluf_(a[12]), a[1] * siluf_(a[13]), a[2] * siluf_(a[14]), a[3] * siluf_(a[15])};
        v2u w; w.x = pk2(u4.x, u4.y); w.y = pk2(u4.z, u4.w); *(v2u*)(U + (size_t)(MP + rs) * D + e0) = w;
        w.x = pk2(g4.x, g4.y); w.y = pk2(g4.z, g4.w); *(v2u*)(GB + (size_t)(MP + rs) * D + e0) = w;
        const int t = rs & 3; if (t >= 2) *(f32x4*)(convs + ((size_t)(rs >> 2) * 2 + (t - 2)) * 1024 + e0) = u4;
    }
}
__device__ __forceinline__ void mini_hgrn_in(int layer, int G) {
    const KPtr p = kparams();
    const int tid = opaque_tid(), lane = tid & 63, wave = tid >> 6, hf = lane >> 5, l31 = lane & 31;
    const bf16* WT = (const bf16*)(p->ws + WS_WHIN) + (size_t)(layer >> 1) * 4096 * 1024; const bf16* HB = (const bf16*)(p->ws + WS_HB);
    float* SPROJ = (float*)(p->ws + WS_SPROJ); bf16* SZ = (bf16*)(p->ws + WS_SZ);
    for (int bt = opaque_bid(); bt < 256; bt += G) {
        const int tt = 4 * (bt & 3) + (wave & 3), nt = 2 * (bt >> 2) + (wave >> 2);
        const int rs = 32 * tt + l31;
        const f32x16 a = mini_tile(WT, 32 * nt + l31, HB, MP + rs, hf);
        const bool isz = (nt >= 64) && ((nt >> 2) & 1);
        const int h = (nt >> 3) & 7;
#pragma unroll
        for (int g = 0; g < 4; ++g) {
            const int np = 32 * nt + 8 * g + 4 * hf;
            if (!isz) *(f32x4*)(SPROJ + (size_t)rs * NPROJ + np) = (f32x4){a[4 * g], a[4 * g + 1], a[4 * g + 2], a[4 * g + 3]};
            else { v2u w; w.x = pk2(siluf_(a[4 * g]), siluf_(a[4 * g + 1])); w.y = pk2(siluf_(a[4 * g + 2]), siluf_(a[4 * g + 3]));
                *(v2u*)(SZ + (size_t)(MP + rs) * D + h * 128 + (np & 127)) = w; }
        }
    }
}
__device__ __forceinline__ void mini_out(int layer, int G) {
    const KPtr p = kparams();
    const int tid = opaque_tid(), lane = tid & 63, wave = tid >> 6, hf = lane >> 5, l31 = lane & 31;
    const bf16* WT = (const bf16*)(p->ws + ((layer & 1) ? WS_WHOUT : WS_WCOUT)) + (size_t)(layer >> 1) * 1024 * 1024; const bf16* YB = (const bf16*)(p->ws + WS_HB);
    float* X = p->out + O_Y;
    const float* xs = layer == 0 ? p->x_sample : X + (size_t)MP * D;
    const float* gate = (const float*)(p->ws + WS_MOD) + layer * 3072 + 2048;
    for (int gw = opaque_bid() + wave * G; gw < 16 * 32; gw += G * NWAVES) {
        const int tt = gw & 15, nt = gw >> 4;
        const int rs = 32 * tt + l31;
        const f32x16 a = mini_tile(WT, 32 * nt + l31, YB, MP + rs, hf);
        const float* xo = xs + (size_t)rs * D; const float* gp = gate + (size_t)(8 + (rs >> 2)) * MODLD; float* xn = X + (size_t)(MP + rs) * D;
#pragma unroll
        for (int g = 0; g < 4; ++g) { const int c = 32 * nt + 8 * g + 4 * hf;
            const f32x4 xv = *(const f32x4*)(xo + c), gv = *(const f32x4*)(gp + c);
            *(f32x4*)(xn + c) = xv + gv * (f32x4){a[4 * g], a[4 * g + 1], a[4 * g + 2], a[4 * g + 3]}; }
    }
}

__device__ __forceinline__ void phase_ada_gemm(LAS unsigned char* lds, int G) {
    const KPtr p = kparams(); unsigned char* ws = p->ws;
    pg8::Gemm g{(const pg8::bf16_t*)(ws + WS_ACT), (const pg8::bf16_t*)(ws + WS_WADA), 256, MODLD, 1024}; pg8::StaticOrder S; S.init(256, MODLD, G, opaque_bid());
    EpiStoreF32 E{(float*)(ws + WS_MOD), MODLD, p->b_ada};
    pg8::gemm_phase<EpiStoreF32, pg8::StaticOrder, true, true>(lds, g, S, E);
}
__device__ __forceinline__ void phase_in_gemm_conv(int j, LAS unsigned char* lds, int G) {
    const KPtr p = kparams(); unsigned char* ws = p->ws;
    const bf16* W = (const bf16*)(ws + WS_WCIN) + (size_t)j * 4096 * 1024;
    pg8::Gemm g{(const pg8::bf16_t*)(ws + WS_HB), W, MP, NPROJ, 1024}; pg8::StaticOrder S; S.init(MP, NPROJ, G, opaque_bid());
    EpiConv E{j};
    pg8::gemm_phase<EpiConv, pg8::StaticOrder, true, true>(lds, g, S, E);
}
__device__ __forceinline__ void phase_in_gemm_hgrn(int layer, LAS unsigned char* lds, int G) {
    const KPtr p = kparams(); unsigned char* ws = p->ws;
    const bf16* W = (const bf16*)(ws + WS_WHIN) + (size_t)(layer >> 1) * 4096 * 1024;
    pg8::Gemm g{(const pg8::bf16_t*)(ws + WS_HB), W, MP, NPROJ, 1024}; pg8::StaticOrder S; S.init(MP, NPROJ, G, opaque_bid());
    EpiHgrn E{layer};
    pg8::gemm_phase<EpiHgrn, pg8::StaticOrder, true, true>(lds, g, S, E);
}
__device__ __forceinline__ void phase_out_gemm(int layer, LAS unsigned char* lds, int G, int dummy = 0) {
    const KPtr p = kparams(); unsigned char* ws = p->ws;
    const int j = layer >> 1;
    const bf16* W = (const bf16*)(ws + ((layer & 1) ? WS_WHOUT : WS_WCOUT)) + (size_t)j * 1024 * 1024;
    pg8::Gemm g{(const pg8::bf16_t*)(ws + WS_HB), W, MP, D, 1024}; pg8::StaticOrder S; S.init(MP, D, G, opaque_bid());
    EpiResid E{layer, dummy};
    pg8::gemm_phase<EpiResid, pg8::StaticOrder, true, true>(lds, g, S, E);
}

#ifndef DUP_LIGHT
#define DUP_LIGHT 0
#endif
#ifndef DUP_G2
#define DUP_G2 0
#endif
#ifndef DUP_G1
#define DUP_G1 0
#endif
#ifndef PROBE_MASK
#define PROBE_MASK 0
#endif
#define PROBE_AMP 4
#define PH(k, stmt) do { unsigned long long t0_ = 0; if ((PROBE_MASK >> (k)) & 1) t0_ = __builtin_amdgcn_s_memrealtime(); stmt; \
    if (((PROBE_MASK >> (k)) & 1) && blockIdx.x == 0) { const unsigned long long t1_ = __builtin_amdgcn_s_memrealtime(); \
        while (__builtin_amdgcn_s_memrealtime() < t1_ + PROBE_AMP * (t1_ - t0_)) __builtin_amdgcn_s_sleep(8); } } while (0)
__global__ void __launch_bounds__(NTHREADS, 2) fwd_megakernel(Params p_unused) {
    extern __shared__ __attribute__((aligned(16))) unsigned char lds_raw[];
    LAS unsigned char* lds = (LAS unsigned char*)lds_raw;
    cg::grid_group grid = cg::this_grid();
    const int G = gridDim.x;
    unsigned* barw = (unsigned*)(kparams()->ws + WS_BAR);
    if (blockIdx.x == 0) for (int i = threadIdx.x; i < XCD_BAR_WORDS; i += NTHREADS) barw[i] = 0u;
    if (threadIdx.x < 16) ((LAS unsigned*)(lds + LDS_MISC))[threadIdx.x] = 0u;
    __syncthreads();

    PH(1, phase_prologue(lds, G); __syncthreads());
    grid.sync();
    (void)xcd_barrier_post(barw, (volatile LAS unsigned*)(lds + LDS_MISC));
#define GRID_BAR() do { XcdBarrier bar_; bar_.bar = (unsigned*)(kparams()->ws + WS_BAR); bar_.x = xb_xcc_id(); bar_.st = (volatile LAS unsigned*)(lds + LDS_MISC); xcd_barrier(bar_); } while (0)
    PH(2, phase_ada_gemm(lds, G));
    GRID_BAR();
#pragma unroll 1
    for (int layer = 0; layer < 4; ++layer) {
        const int j = layer >> 1; const bool is_conv = (layer & 1) == 0;
        PH(3, phase_norm(layer, G));
        GRID_BAR();
        if (is_conv) {
            PH(4, mini_conv_in(j, G); __syncthreads());
            PH(5, phase_in_gemm_conv(j, lds, G));
            GRID_BAR();
            PH(6, phase_conv_y(j, G)); }
        else {
            PH(7, mini_hgrn_in(layer, G); __syncthreads());
            PH(8, phase_in_gemm_hgrn(layer, lds, G));
            GRID_BAR();
            PH(9, phase_hgrn_rec(layer, j, lds, G));
            GRID_BAR();
            PH(10, phase_hgrn_y(j, G));
        }
        GRID_BAR();
        PH(11, mini_out(layer, G); __syncthreads());
        PH(12, phase_out_gemm(layer, lds, G));
        GRID_BAR();
    }
    PH(13, phase_final(G));
}

extern "C" void kernel_launch(void* const* d_in, const int* in_sizes, int n_in, void* d_out, int out_size, void* d_ws, size_t ws_size, hipStream_t stream) {
    static int grid_blocks = 0;
    if (grid_blocks == 0) {
        if (n_in != 17 || ws_size < WS_END) { fprintf(stderr, "kernel_launch: unexpected n_in %d or ws_size %zu (< %zu)\n", n_in, ws_size, (size_t)WS_END); grid_blocks = -1; return; }
        int dev = 0, cus = 0, per_cu = 0;
        hipGetDevice(&dev);
        hipDeviceGetAttribute(&cus, hipDeviceAttributeMultiprocessorCount, dev);
        if (hipFuncSetAttribute((const void*)fwd_megakernel, hipFuncAttributeMaxDynamicSharedMemorySize, LDS_BYTES) != hipSuccess) { fprintf(stderr, "kernel_launch: hipFuncSetAttribute failed\n"); grid_blocks = -1; return; }
        hipOccupancyMaxActiveBlocksPerMultiprocessor(&per_cu, (const void*)fwd_megakernel, NTHREADS, LDS_BYTES);
        if (per_cu < 1) { fprintf(stderr, "kernel_launch: occupancy query returned %d\n", per_cu); per_cu = 1; }
        grid_blocks = cus * per_cu;
    }
    if (grid_blocks < 0) return;
    Params p{};
    p.x_prompt = (const float*)d_in[0]; p.x_sample = (const float*)d_in[1]; p.state_conv = (const float*)d_in[2]; p.state_hgrn = (const float*)d_in[3];
    p.c_prompt = (const float*)d_in[4]; p.c_sample = (const float*)d_in[5]; p.norm_g = (const float*)d_in[6]; p.w_ada = (const float*)d_in[7]; p.b_ada = (const float*)d_in[8];
    p.conv_w_in = (const float*)d_in[9]; p.conv_w = (const float*)d_in[10]; p.conv_w_out = (const float*)d_in[11]; p.hgrn_w_in = (const float*)d_in[12];
    p.hgrn_lb = (const float*)d_in[13]; p.hgrn_onorm_g = (const float*)d_in[14]; p.hgrn_w_out = (const float*)d_in[15]; p.final_norm_g = (const float*)d_in[16];
    p.out = (float*)d_out; p.ws = (unsigned char*)d_ws;
    void* args[] = {&p};
    hipError_t e = hipLaunchCooperativeKernel((const void*)fwd_megakernel, dim3(grid_blocks), dim3(NTHREADS), args, LDS_BYTES, stream);
    if (e != hipSuccess) fprintf(stderr, "cooperative launch failed: %s (grid %d)\n", hipGetErrorString(e), grid_blocks);
}
```
